# Optimizing an MI355X kernel written in HIP

```python
import math
import jax, jax.numpy as jnp
from jax import lax
import numpy as np

D_MODEL = 1024
BATCH = 8
SEQ = 4096
DEPTH = 1

HEAD_DIM = 64
N_SLOTS = 8
GROUP_PATTERNS = ((128, 1), (512, 4), (2048, 16))
N_ATTN_GROUPS = len(GROUP_PATTERNS)
ATTN_WIDTH = N_SLOTS * HEAD_DIM
QKV_WIDTH = N_ATTN_GROUPS * ATTN_WIDTH
BLOCK = 128
SSM_WIDTH = 512
SSM_GROUP = 16
SSM_GROUPS = SSM_WIDTH // SSM_GROUP
SSM_STATE = 64
DT_MIN = 1e-3
DT_MAX = 1e-1
N_BRANCHES = 2
D_IN = 3 * QKV_WIDTH + ATTN_WIDTH + 2 * SSM_WIDTH + N_BRANCHES * D_MODEL
DEEPNORM_ALPHA = (2.0 * DEPTH) ** 0.25
DEEPNORM_BETA = (8.0 * DEPTH) ** -0.25
LN_EPS = 1e-5

kernel_name = "hybrid_dilated_attn_s5_gated_deepnorm"


def _alibi_slopes(n):
    return 2.0 ** (-8.0 * jnp.arange(1, n + 1, dtype=jnp.float32) / n)


def _layer_norm(h, g, b):
    h = h.astype(jnp.float32)
    mu = h.mean(-1, keepdims=True)
    var = jnp.mean(jnp.square(h - mu), -1, keepdims=True)
    return (h - mu) * lax.rsqrt(var + LN_EPS) * g.astype(jnp.float32) + b.astype(jnp.float32)


def _dilated_group(q, k, v, window, dilation, slopes):
    b, L, h, dh = q.shape
    r = dilation
    span = r * BLOCK
    Lp = -(-L // span) * span
    n_sub = Lp // r
    nb = n_sub // BLOCK
    pad = ((0, 0), (0, Lp - L), (0, 0), (0, 0))

    def to_sub(t):
        t = jnp.pad(t, pad).reshape(b, n_sub, r, h, dh).transpose(0, 2, 3, 1, 4)
        return t.reshape(b, r, h, nb, BLOCK, dh)

    def band(t):
        prev = jnp.pad(t, ((0, 0), (0, 0), (0, 0), (1, 0), (0, 0), (0, 0)))[:, :, :, :-1]
        return jnp.concatenate([prev, t], axis=4)

    qs = to_sub(q)
    kb = band(to_sub(k))
    vb = band(to_sub(v))
    s = jnp.einsum('brhnqd,brhnkd->brhnqk', qs, kb,
                   preferred_element_type=jnp.float32) / math.sqrt(dh)
    qi = jnp.arange(BLOCK)[:, None]
    kj = jnp.arange(2 * BLOCK)[None, :]
    dist = BLOCK + qi - kj
    in_range = (jnp.arange(nb)[:, None, None] > 0) | (kj[None] >= BLOCK)
    valid = (dist >= 0) & (dist <= window // r) & in_range
    alibi = -slopes[:, None, None, None] * (dist * r).astype(jnp.float32)
    s = jnp.where(valid, s + alibi[None, None], -jnp.inf)
    m = s.max(-1)
    p = jnp.exp(s - m[..., None])
    l = p.sum(-1)
    o = jnp.einsum('brhnqk,brhnkd->brhnqd', p, vb.astype(jnp.float32)) / l[..., None]
    o = o.reshape(b, r, h, n_sub, dh).transpose(0, 3, 1, 2, 4).reshape(b, Lp, h, dh)[:, :L]
    m = m.reshape(b, r, h, n_sub).transpose(0, 3, 1, 2).reshape(b, Lp, h)[:, :L]
    l = l.reshape(b, r, h, n_sub).transpose(0, 3, 1, 2).reshape(b, Lp, h)[:, :L]
    return o, m, l


def _dilated_mixture(q, k, v):
    slopes = _alibi_slopes(N_SLOTS)
    outs, maxes, sums = [], [], []
    for g, (win, dil) in enumerate(GROUP_PATTERNS):
        o, m, l = _dilated_group(q[:, :, g], k[:, :, g], v[:, :, g], win, dil, slopes)
        outs.append(o)
        maxes.append(m)
        sums.append(l)
    m_all = jnp.stack(maxes)
    w = jnp.stack(sums) * jnp.exp(m_all - m_all.max(0, keepdims=True))
    return jnp.sum(w[..., None] * jnp.stack(outs), 0) / jnp.sum(w, 0)[..., None]


def _s5(u, lam_re, lam_im, log_dt, b_re, b_im, c_re, c_im, d_skip):
    f32 = jnp.float32
    bsz, L, _ = u.shape
    uf = u.astype(f32)
    ug = uf.reshape(bsz, L, SSM_GROUPS, SSM_GROUP)
    lr, li = lam_re.astype(f32), lam_im.astype(f32)
    dt = jnp.exp(log_dt.astype(f32))[:, None]
    mag = jnp.exp(lr * dt)
    ab_re, ab_im = mag * jnp.cos(li * dt), mag * jnp.sin(li * dt)
    nr, ni = ab_re - 1.0, ab_im
    den = lr * lr + li * li
    coef_re = (nr * lr + ni * li) / den
    coef_im = (ni * lr - nr * li) / den
    br, bi = b_re.astype(f32), b_im.astype(f32)
    bb_re = coef_re[..., None] * br - coef_im[..., None] * bi
    bb_im = coef_re[..., None] * bi + coef_im[..., None] * br
    bu_re = jnp.einsum('gpc,blgc->blgp', bb_re, ug)
    bu_im = jnp.einsum('gpc,blgc->blgp', bb_im, ug)
    a_re = jnp.broadcast_to(ab_re, bu_re.shape)
    a_im = jnp.broadcast_to(ab_im, bu_im.shape)

    def combine(e1, e2):
        a1r, a1i, b1r, b1i = e1
        a2r, a2i, b2r, b2i = e2
        return (a2r * a1r - a2i * a1i,
                a2r * a1i + a2i * a1r,
                a2r * b1r - a2i * b1i + b2r,
                a2r * b1i + a2i * b1r + b2i)

    _, _, xr, xi = lax.associative_scan(combine, (a_re, a_im, bu_re, bu_im), axis=1)
    y = (jnp.einsum('gcp,blgp->blgc', c_re.astype(f32), xr)
         - jnp.einsum('gcp,blgp->blgc', c_im.astype(f32), xi))
    return y.reshape(bsz, L, SSM_WIDTH) + d_skip.astype(f32) * uf


def setup_inputs(seed: int = 0) -> dict:
    key = jax.random.key(seed)
    ks = jax.random.split(key, 20)
    f32 = jnp.float32

    def nrm(k, shape, scale):
        return jax.random.normal(k, shape, f32) * scale

    x = jax.random.normal(ks[0], (BATCH, SEQ, D_MODEL), f32)
    w_in = nrm(ks[1], (DEPTH, D_MODEL, D_IN), D_MODEL ** -0.5)
    w_in = w_in.at[:, :, 2 * QKV_WIDTH:3 * QKV_WIDTH].multiply(DEEPNORM_BETA)
    lam_re = -0.5 + nrm(ks[2], (DEPTH, SSM_GROUPS, SSM_STATE), 0.01)
    lam_im = (math.pi * jnp.arange(SSM_STATE, dtype=f32))[None, None, :] + nrm(ks[3], (DEPTH, SSM_GROUPS, SSM_STATE), 0.01)
    log_dt = jax.random.uniform(ks[4], (DEPTH, SSM_GROUPS), f32, math.log(DT_MIN), math.log(DT_MAX))
    b_re = nrm(ks[5], (DEPTH, SSM_GROUPS, SSM_STATE, SSM_GROUP), (2.0 * SSM_GROUP) ** -0.5)
    b_im = nrm(ks[6], (DEPTH, SSM_GROUPS, SSM_STATE, SSM_GROUP), (2.0 * SSM_GROUP) ** -0.5)
    c_re = nrm(ks[7], (DEPTH, SSM_GROUPS, SSM_GROUP, SSM_STATE), (2.0 * SSM_STATE) ** -0.5)
    c_im = nrm(ks[8], (DEPTH, SSM_GROUPS, SSM_GROUP, SSM_STATE), (2.0 * SSM_STATE) ** -0.5)
    d_skip = nrm(ks[9], (DEPTH, SSM_WIDTH), 1.0)
    w_glu = nrm(ks[10], (DEPTH, SSM_WIDTH, SSM_WIDTH), SSM_WIDTH ** -0.5)
    b_glu = nrm(ks[11], (DEPTH, SSM_WIDTH), 0.01)
    w_attn_up = nrm(ks[12], (DEPTH, ATTN_WIDTH, D_MODEL), ATTN_WIDTH ** -0.5)
    w_ssm_up = nrm(ks[13], (DEPTH, SSM_WIDTH, D_MODEL), SSM_WIDTH ** -0.5)
    w_o = nrm(ks[14], (DEPTH, D_MODEL, D_MODEL), DEEPNORM_BETA * D_MODEL ** -0.5)
    ln_g = 1.0 + nrm(ks[15], (DEPTH, D_MODEL), 0.01)
    ln_b = nrm(ks[16], (DEPTH, D_MODEL), 0.01)
    return {"x": x, "w_in": w_in, "lam_re": lam_re, "lam_im": lam_im, "log_dt": log_dt,
            "b_re": b_re, "b_im": b_im, "c_re": c_re, "c_im": c_im, "d_skip": d_skip,
            "w_glu": w_glu, "b_glu": b_glu, "w_attn_up": w_attn_up, "w_ssm_up": w_ssm_up,
            "w_o": w_o, "ln_g": ln_g, "ln_b": ln_b}


def reference(x, w_in, lam_re, lam_im, log_dt, b_re, b_im, c_re, c_im, d_skip,
              w_glu, b_glu, w_attn_up, w_ssm_up, w_o, ln_g, ln_b):
    bsz, L, _ = x.shape
    h = x
    for layer in range(DEPTH):
        proj = jnp.einsum('bld,de->ble', h, w_in[layer])
        o0 = 0
        q = proj[..., o0:o0 + QKV_WIDTH]; o0 += QKV_WIDTH
        k = proj[..., o0:o0 + QKV_WIDTH]; o0 += QKV_WIDTH
        v = proj[..., o0:o0 + QKV_WIDTH]; o0 += QKV_WIDTH
        z_a = proj[..., o0:o0 + ATTN_WIDTH]; o0 += ATTN_WIDTH
        u_s = proj[..., o0:o0 + SSM_WIDTH]; o0 += SSM_WIDTH
        z_s = proj[..., o0:o0 + SSM_WIDTH]; o0 += SSM_WIDTH
        gate_logits = proj[..., o0:o0 + N_BRANCHES * D_MODEL].astype(jnp.float32)
        hs = (bsz, L, N_ATTN_GROUPS, N_SLOTS, HEAD_DIM)
        attn = _dilated_mixture(q.reshape(hs), k.reshape(hs), v.reshape(hs)).reshape(bsz, L, ATTN_WIDTH)
        attn = attn * jax.nn.silu(z_a.astype(jnp.float32))
        y_a = jnp.einsum('blc,cd->bld', attn, w_attn_up[layer])
        y = jax.nn.gelu(_s5(u_s, lam_re[layer], lam_im[layer], log_dt[layer], b_re[layer], b_im[layer],
                            c_re[layer], c_im[layer], d_skip[layer]))
        y = y * jax.nn.sigmoid(jnp.einsum('blc,ce->ble', y, w_glu[layer]) + b_glu[layer])
        y = y * jax.nn.silu(z_s.astype(jnp.float32))
        y_s = jnp.einsum('blc,cd->bld', y, w_ssm_up[layer])
        g_a = jax.nn.sigmoid(gate_logits[..., :D_MODEL])
        g_s = jax.nn.sigmoid(gate_logits[..., D_MODEL:])
        merged = g_a * y_a + g_s * y_s
        out = jnp.einsum('bld,de->ble', merged, w_o[layer])
        h = _layer_norm(DEEPNORM_ALPHA * h.astype(jnp.float32) + out, ln_g[layer], ln_b[layer]).astype(x.dtype)
    return h
```

```cpp
#include <hip/hip_runtime.h>
#include <hip/hip_cooperative_groups.h>
#include <cstdio>
#include <cstdint>
namespace cg = cooperative_groups;

#define LAS __attribute__((address_space(3)))
typedef unsigned short bf16_t;
typedef short bf16x8 __attribute__((ext_vector_type(8)));
typedef float f32x4 __attribute__((ext_vector_type(4)));
typedef float f32x2 __attribute__((ext_vector_type(2)));
typedef unsigned u32x4 __attribute__((ext_vector_type(4)));
typedef unsigned u32x2 __attribute__((ext_vector_type(2)));

constexpr int NB = 8, SEQ = 4096, MT = NB * SEQ, DM = 1024, DIN = 8192, QKVW = 1536, AW = 512, SW = 512;
constexpr int SG = 32, SC = 16, SP = 64;
constexpr float LN_EPS = 1e-5f;
constexpr float DN_ALPHA = 1.189207115002721f;

constexpr size_t MiB = 1u << 20;
constexpr size_t WS_XB = 0;
constexpr size_t WS_AT2 = 0;
constexpr size_t WS_YG = 480 * MiB;
constexpr size_t WS_WIN = 64 * MiB;
constexpr size_t WS_WGLU = 80 * MiB, WS_WUP = 81 * MiB, WS_WO = 83 * MiB;
constexpr size_t WS_SSMP = 85 * MiB;
constexpr size_t WS_CHST = 86 * MiB;
constexpr size_t WS_BAR = 90 * MiB;
constexpr size_t WS_STATS = WS_BAR + 16384, WS_CNT = WS_STATS + (size_t)MT * 2 * 4, WS_SSMC = WS_CNT + 128 * 256, BAR_BYTES = 16384 + (size_t)MT * 2 * 4 + 128 * 256 + 256;
constexpr size_t WS_Q = 96 * MiB, WS_K = 192 * MiB, WS_VT = 288 * MiB;
constexpr size_t WS_ZA = 384 * MiB, WS_US = 416 * MiB, WS_ZS = 448 * MiB;
constexpr size_t WS_MG = 288 * MiB;
constexpr size_t WS_END = 512 * MiB;

constexpr int SPF_A = 0;
constexpr int SPF_ACH = SPF_A + SG * SP * 2;
constexpr int SPF_BBR = SPF_ACH + SG * SP * 2;
constexpr int SPF_BBI = SPF_BBR + SG * SP * SC;
constexpr int SPF_A16 = SPF_BBI + SG * SP * SC;
constexpr int SPF_END = SPF_A16 + SG * SP * 2;
constexpr size_t WS_W16R = 88 * MiB, WS_W16I = 89 * MiB;

constexpr int LDS_BYTES = 147456;

__device__ __forceinline__ int opaque_tid() { int t = threadIdx.x; asm volatile("" : "+v"(t)); return t; }
typedef __bf16 bf16x2_t __attribute__((ext_vector_type(2)));
typedef float f32x16 __attribute__((ext_vector_type(16)));
#define MFMA32(a, b, c) __builtin_amdgcn_mfma_f32_32x32x16_bf16((a), (b), (c), 0, 0, 0)
__device__ __forceinline__ unsigned cvt_pk_bf16(float lo, float hi) { f32x2 v = {lo, hi}; bf16x2_t r = __builtin_convertvector(v, bf16x2_t); return __builtin_bit_cast(unsigned, r); }
__device__ __forceinline__ float bf_lo(unsigned w) { return __builtin_bit_cast(float, w << 16); }
__device__ __forceinline__ float bf_hi(unsigned w) { return __builtin_bit_cast(float, w & 0xffff0000u); }
__device__ __forceinline__ float bf2f(bf16_t b) { return __builtin_bit_cast(float, ((unsigned)b) << 16); }
__device__ __forceinline__ float sigmoidf_(float v) { return __builtin_amdgcn_rcpf(1.f + __expf(-v)); }
__device__ __forceinline__ float siluf_(float v) { return v * sigmoidf_(v); }
__device__ __forceinline__ float gelu_tanh(float v) { const float z = 1.5957691216057308f * (v + 0.044715f * v * v * v); return v * sigmoidf_(z); }
__device__ __forceinline__ float wave_sum(float v) {
#pragma unroll
    for (int o = 1; o < 64; o <<= 1) v += __shfl_xor(v, o);
    return v;
}
__device__ __forceinline__ float wave_max(float v) {
#pragma unroll
    for (int o = 1; o < 64; o <<= 1) v = fmaxf(v, __shfl_xor(v, o));
    return v;
}

namespace pg8 {
constexpr int BM = 256, BK = 64, HALF = 128, HTB = HALF * BK * 2, STAGE_BYTES = 8 * HTB, NXCD = 8, WGM = 8;
__host__ __device__ __forceinline__ int lds_byte(int r, int c) { const int st = (r >> 4) * 2 + (c >> 5), rr = r & 15, cc = c & 31, ob = rr * 64 + cc * 2; return st * 1024 + (ob ^ (((ob >> 9) & 1) << 5)); }
__host__ __device__ __forceinline__ void stage_rc(int b, int& R, int& C) { const int st = b / 1024, sb = b % 1024, swz = sb ^ (((sb >> 9) & 1) << 5); R = (st >> 1) * 16 + swz / 64; C = (st & 1) * 32 + (swz % 64) / 2; }
__host__ __device__ __forceinline__ int perm32(int rho) { const int n = rho >> 4, i = rho & 15; return 8 * (i >> 2) + 4 * n + (i & 3); }

struct Unit { int pm, pn; };
struct Gemm { const bf16_t* A; const bf16_t* Bt; int K; int rsA; int rsB; };

struct Order {
    int nM, nN, nwg, G, c, mode, r, rep, gi;
    __device__ __forceinline__ void init(int nM_, int nN_, int G_, int c_, int mode_, int r_, int rep_ = 1, int gi_ = 0) { nM = nM_; nN = nN_; nwg = nM * nN; G = G_; c = c_; mode = mode_; r = r_; rep = rep_; gi = gi_; }
    __device__ __forceinline__ bool next(int i, Unit& u) const {
        const long L = (long)i * G + c; if (L >= (long)nwg * rep) return false;
        int wgid = (int)(L % nwg); { const int q = nwg / NXCD, rr = nwg % NXCD, xcd = wgid % NXCD, off = wgid / NXCD; wgid = (xcd < rr ? xcd * (q + 1) : rr * (q + 1) + (xcd - rr) * q) + off; }
        const int nig = WGM * nN, gid = wgid / nig, fm = gid * WGM, gsz = (nM - fm) < WGM ? (nM - fm) : WGM;
        u.pm = fm + ((wgid % nig) % gsz); u.pn = (wgid % nig) / gsz; return true;
    }
    __device__ __forceinline__ size_t tok0(int t) const { const int b = t >> 4, q = t & 15, pos0 = q * 256, NS = SEQ / r, ph = pos0 / NS, n0 = pos0 % NS; return (size_t)(b * SEQ + n0 * r + ph); }
    __device__ __forceinline__ size_t a_off(const Unit& u, int K) const {
        if (mode == 3) return tok0(u.pm) * K * 2;
        return (size_t)u.pm * 256 * K * 2;
    }
    __device__ __forceinline__ size_t b_off(const Unit& u, int K) const {
        if (mode == 0) return (size_t)u.pn * 256 * K * 2;
        if (mode == 1) { const int wrow = u.pn < 2 ? 256 * u.pn : u.pn < 4 ? QKVW + 256 * (u.pn - 2) : 3 * QKVW + 256 * (u.pn - 4); return (size_t)wrow * K * 2; }
        if (mode == 3) { const int wrow = u.pn < 2 ? gi * 512 + 256 * u.pn : QKVW + gi * 512 + 256 * (u.pn - 2); return (size_t)wrow * K * 2; }
        return tok0(u.pn) * K * 2;
    }
};

template <class Epi, bool ALIGN_EPI = true>
__device__ __forceinline__ void gemm_phase(LAS unsigned char* lds, const Gemm g, const Order& S, const Epi& E) {
    const int tid = opaque_tid(), wid = __builtin_amdgcn_readfirstlane(tid >> 6), lane = tid & 63, wr = wid >> 2, wc = wid & 3, fr = lane & 15, fq = lane >> 4;
    const int K = g.K, nt = K / BK;
    unsigned voffA[2], voffB[2];
#pragma unroll
    for (int i = 0; i < 2; ++i) { int R, C; stage_rc(tid * 16 + i * 8192, R, C); const int Rb = Epi::PERM ? ((R & ~31) + perm32(R & 31)) : R;
        voffA[i] = (unsigned)(R * g.rsA * K + C) * 2u; voffB[i] = (unsigned)(Rb * g.rsB * K + C) * 2u; }
    const size_t kstep = (size_t)(BK * 2);
    const size_t hstep = (size_t)HALF * K * 2 * (size_t)g.rsA;
    const size_t hstepB = (size_t)HALF * K * 2 * (size_t)g.rsB;
    const unsigned ldsw = (unsigned)wid * 1024u;
    const int aoff = lds_byte(wr * 64 + fr, fq * 8), boff = lds_byte(wc * 32 + fr, fq * 8);
#define PG8_SA(b, h) (((b) * 2 + (h)) * HTB)
#define PG8_SB(b, h) ((4 + (b) * 2 + (h)) * HTB)
#define PG8_STAGE(bufoff, gbase, voff) do { _Pragma("unroll") for (int _i = 0; _i < 2; ++_i) \
        __builtin_amdgcn_global_load_lds((const unsigned*)((const char*)(gbase) + (voff)[_i]), (LAS unsigned*)(lds + (bufoff) + ldsw + _i * 8192), 16, 0, 0); } while (0)
#define PG8_LDA(dst, b, h) do { _Pragma("unroll") for (int m = 0; m < 4; ++m) _Pragma("unroll") for (int k = 0; k < 2; ++k) dst[m][k] = *(const LAS bf16x8*)(lds + PG8_SA(b, h) + aoff + m * 2048 + k * 1024); } while (0)
#define PG8_LDB(dst, b, h) do { _Pragma("unroll") for (int n = 0; n < 2; ++n) _Pragma("unroll") for (int k = 0; k < 2; ++k) dst[n][k] = *(const LAS bf16x8*)(lds + PG8_SB(b, h) + boff + n * 2048 + k * 1024); } while (0)
#define PG8_MMA(ai, bj, At, Bt) do { __builtin_amdgcn_s_setprio(1); _Pragma("unroll") for (int m = 0; m < 4; ++m) _Pragma("unroll") for (int n = 0; n < 2; ++n) _Pragma("unroll") for (int k = 0; k < 2; ++k) \
        acc[ai][bj][m][n] = __builtin_amdgcn_mfma_f32_16x16x32_bf16(Bt[n][k], At[m][k], acc[ai][bj][m][n], 0, 0, 0); __builtin_amdgcn_s_setprio(0); } while (0)
#define PG8_WAIT_V(n) asm volatile("s_waitcnt vmcnt(" #n ")" ::: "memory")
#define PG8_WAIT_L(n) asm volatile("s_waitcnt lgkmcnt(" #n ")" ::: "memory")
#define PG8_BAR __builtin_amdgcn_s_barrier()
#define PG8_SCHED __builtin_amdgcn_sched_barrier(0)
    Unit cur, nxt; int ui = 0;
    if (!S.next(0, cur)) return;
    f32x4 acc[2][2][4][2];
#pragma unroll
    for (int a = 0; a < 2; ++a)
#pragma unroll
        for (int b = 0; b < 2; ++b)
#pragma unroll
            for (int m = 0; m < 4; ++m)
#pragma unroll
                for (int n = 0; n < 2; ++n) acc[a][b][m][n] = (f32x4){0.f, 0.f, 0.f, 0.f};
    bf16x8 At[4][2], B0[2][2], B1[2][2];
    const char* cA = (const char*)g.A + S.a_off(cur, K); const char* cB = (const char*)g.Bt + S.b_off(cur, K);
    PG8_STAGE(PG8_SB(0, 0), cB, voffB); PG8_STAGE(PG8_SB(0, 1), cB + hstepB, voffB); PG8_STAGE(PG8_SA(0, 0), cA, voffA); PG8_STAGE(PG8_SA(0, 1), cA + hstep, voffA);
    if (wr == 1) PG8_BAR;
    PG8_WAIT_V(2); PG8_BAR;
    PG8_STAGE(PG8_SB(1, 0), cB + kstep, voffB); PG8_STAGE(PG8_SA(1, 0), cA + kstep, voffA); PG8_STAGE(PG8_SB(1, 1), cB + hstepB + kstep, voffB);
    PG8_WAIT_V(6); PG8_BAR;
    for (;;) {
        const bool has_next = S.next(ui + 1, nxt);
        const char* nA = has_next ? (const char*)g.A + S.a_off(nxt, K) : cA; const char* nB = has_next ? (const char*)g.Bt + S.b_off(nxt, K) : cB;
        for (int t = 0; t < nt; t += 2) {
            const bool last = (t == nt - 2);
            const char* a1 = cA + (size_t)(t + 1) * kstep;
            const char* a2 = last ? nA : cA + (size_t)(t + 2) * kstep; const char* b2 = last ? nB : cB + (size_t)(t + 2) * kstep;
            const char* a3 = a2 + kstep; const char* b3 = b2 + kstep;
            if constexpr (Epi::MID) { if (t == nt / 2) E.mid(acc, cur, wr, wc, fr, fq); }
            PG8_LDB(B0, 0, 0); PG8_LDB(B1, 0, 1); PG8_SCHED; PG8_LDA(At, 0, 0); PG8_STAGE(PG8_SA(1, 1), a1 + hstep, voffA);
            PG8_WAIT_V(8); PG8_WAIT_L(0); PG8_BAR; PG8_MMA(0, 0, At, B0); PG8_MMA(0, 1, At, B1); PG8_BAR; PG8_SCHED;
            PG8_LDA(At, 0, 1); PG8_STAGE(PG8_SB(0, 0), b2, voffB); PG8_STAGE(PG8_SB(0, 1), b2 + hstepB, voffB); PG8_STAGE(PG8_SA(0, 0), a2, voffA);
            PG8_WAIT_V(8); PG8_WAIT_L(0); PG8_BAR; PG8_MMA(1, 0, At, B0); PG8_MMA(1, 1, At, B1); PG8_BAR; PG8_SCHED;
            PG8_LDB(B0, 1, 0); PG8_LDB(B1, 1, 1); PG8_SCHED; PG8_LDA(At, 1, 0); PG8_STAGE(PG8_SA(0, 1), a2 + hstep, voffA);
            PG8_WAIT_V(8); PG8_WAIT_L(0); PG8_BAR; PG8_MMA(0, 0, At, B0); PG8_MMA(0, 1, At, B1); PG8_BAR; PG8_SCHED;
            PG8_LDA(At, 1, 1); PG8_STAGE(PG8_SB(1, 0), b3, voffB); PG8_STAGE(PG8_SB(1, 1), b3 + hstepB, voffB); PG8_STAGE(PG8_SA(1, 0), a3, voffA);
            PG8_WAIT_V(8); PG8_WAIT_L(0); PG8_BAR; PG8_MMA(1, 0, At, B0); PG8_MMA(1, 1, At, B1); PG8_BAR; PG8_SCHED;
        }
        if constexpr (ALIGN_EPI) { if (wr == 0) PG8_BAR; }
        if constexpr (!Epi::AFTER) E(acc, cur, wr, wc, fr, fq);
        if (!has_next) break;
#pragma unroll
        for (int a = 0; a < 2; ++a)
#pragma unroll
            for (int b = 0; b < 2; ++b)
#pragma unroll
                for (int m = 0; m < 4; ++m)
#pragma unroll
                    for (int n = 0; n < 2; ++n) acc[a][b][m][n] = (f32x4){0.f, 0.f, 0.f, 0.f};
        cur = nxt; cA = nA; cB = nB; ++ui;
        if constexpr (ALIGN_EPI) { if (wr == 1) PG8_BAR; }
    }
    PG8_WAIT_V(0);
    if constexpr (!ALIGN_EPI) { if (wr == 0) PG8_BAR; }
    PG8_BAR;
    if constexpr (Epi::AFTER) E.after(acc, cur, wr, wc, fr, fq, lds);
#undef PG8_SA
#undef PG8_SB
#undef PG8_STAGE
#undef PG8_LDA
#undef PG8_LDB
#undef PG8_MMA
#undef PG8_WAIT_V
#undef PG8_WAIT_L
#undef PG8_BAR
#undef PG8_SCHED
}

__device__ __forceinline__ u32x4 pack8(f32x4 v0, f32x4 v1) { u32x4 w; w.x = cvt_pk_bf16(v0[0], v0[1]); w.y = cvt_pk_bf16(v0[2], v0[3]); w.z = cvt_pk_bf16(v1[0], v1[1]); w.w = cvt_pk_bf16(v1[2], v1[3]); return w; }
__device__ __forceinline__ void unpack8(u32x4 w, f32x4& a, f32x4& b) { a = (f32x4){bf_lo(w.x), bf_hi(w.x), bf_lo(w.y), bf_hi(w.y)}; b = (f32x4){bf_lo(w.z), bf_hi(w.z), bf_lo(w.w), bf_hi(w.w)}; }

__device__ __forceinline__ void store_tile_bf16(const f32x4 (&acc)[2][2][4][2], bf16_t* base, int ld, int row0, int col0) {
#pragma unroll
    for (int ai = 0; ai < 2; ++ai)
#pragma unroll
        for (int m = 0; m < 4; ++m) { bf16_t* rowp = base + (size_t)(row0 + ai * HALF + m * 16) * ld + col0;
#pragma unroll
            for (int bj = 0; bj < 2; ++bj) __builtin_nontemporal_store(pack8(acc[ai][bj][m][0], acc[ai][bj][m][1]), (u32x4*)(rowp + bj * HALF)); }
}
__device__ __forceinline__ size_t qk_addr(int b, int g, int h, int c, int pos) { return (((((size_t)(b * 3 + g) * 8 + h) * (SEQ / 32) + (pos >> 5)) * 8 + c) * 32 + (pos & 31)) * 8; }
__device__ __forceinline__ void store_tile_qk(const f32x4 (&acc)[2][2][4][2], bf16_t* base, int b, int g, int hb, int pos0, int wr, int wc, int fr, int fq) {
#pragma unroll
    for (int bj = 0; bj < 2; ++bj) { const int j = bj * HALF + wc * 32 + 8 * fq; bf16_t* cp = base + qk_addr(b, g, hb + (j >> 6), (j & 63) >> 3, pos0 + wr * 64 + fr);
#pragma unroll
        for (int ai = 0; ai < 2; ++ai)
#pragma unroll
            for (int m = 0; m < 4; ++m) __builtin_nontemporal_store(pack8(acc[ai][bj][m][0], acc[ai][bj][m][1]), (u32x4*)(cp + (size_t)((ai * 4 + (m >> 1)) * 8 * 32 + (m & 1) * 16) * 8)); }
}
__device__ __forceinline__ size_t tp_off(int wr, int wc, int ai, int m, int bj, int lane) { return (size_t)(((((wr * 4 + wc) * 2 + ai) * 4 + m) * 2 + bj) * 512 + lane * 8); }
__device__ __forceinline__ void store_tile_priv(const f32x4 (&acc)[2][2][4][2], bf16_t* tile, int wr, int wc, int lane) {
#pragma unroll
    for (int ai = 0; ai < 2; ++ai)
#pragma unroll
        for (int m = 0; m < 4; ++m)
#pragma unroll
            for (int bj = 0; bj < 2; ++bj) __builtin_nontemporal_store(pack8(acc[ai][bj][m][0], acc[ai][bj][m][1]), (u32x4*)(tile + tp_off(wr, wc, ai, m, bj, lane)));
}
struct EpiProj {
    static constexpr bool PERM = true, MID = false, AFTER = false;
    unsigned char* ws; bf16_t* GL;
    __device__ __forceinline__ void operator()(const f32x4 (&acc)[2][2][4][2], const Unit& u, int wr, int wc, int fr, int fq) const {
        const int pn = u.pn;
        if (pn < 4) { store_tile_qk(acc, (bf16_t*)(ws + (pn < 2 ? WS_Q : WS_K)), u.pm >> 4, 0, 4 * (pn & 1), (u.pm & 15) * 256, wr, wc, fr, fq); return; }
        if (pn >= 10) {
            int lane = fr + 16 * fq; asm volatile("" : "+v"(lane));
            bf16_t* rb = GL + (size_t)(u.pm * 8 + (pn - 10)) * 32768 + (size_t)((wr * 4 + wc) * 8 * 512 + lane * 8);
#pragma unroll
            for (int ai = 0; ai < 2; ++ai) {
                bf16_t* rp = rb + ai * 4 * 512; bf16_t* gp = rp + (size_t)(MT / 256) * 8 * 32768;
#pragma unroll
                for (int m = 0; m < 4; ++m) { f32x4 r0, r1, g0, g1;
#pragma unroll
                    for (int j = 0; j < 4; ++j) {
                        const float es0 = __expf(-fmaxf(acc[ai][1][m][0][j], -80.f)), es1 = __expf(-fmaxf(acc[ai][1][m][1][j], -80.f));
                        g0[j] = __builtin_amdgcn_rcpf(1.f + es0); g1[j] = __builtin_amdgcn_rcpf(1.f + es1);
                        r0[j] = (1.f + es0) * __builtin_amdgcn_rcpf(1.f + __expf(-acc[ai][0][m][0][j])); r1[j] = (1.f + es1) * __builtin_amdgcn_rcpf(1.f + __expf(-acc[ai][0][m][1][j])); }
                    __builtin_nontemporal_store(pack8(g0, g1), (u32x4*)(gp + m * 512));
                    __builtin_nontemporal_store(pack8(r0, r1), (u32x4*)(rp + m * 512));
                    __builtin_amdgcn_sched_barrier(0); }
            }
            return; }
        if (pn >= 8) { store_tile_priv(acc, (bf16_t*)(ws + WS_ZS) + (size_t)(u.pm * 2 + (pn - 8)) * 65536, wr, wc, fr + 16 * fq); return; }
        const size_t off = pn < 6 ? WS_ZA : WS_US;
        store_tile_priv(acc, (bf16_t*)(ws + off) + (size_t)(u.pm * 2 + (pn & 1)) * 65536, wr, wc, fr + 16 * fq);
    }
};
struct EpiQK {
    static constexpr bool PERM = true, MID = false, AFTER = false;
    bf16_t *Q, *Kb; int gi;
    __device__ __forceinline__ void operator()(const f32x4 (&acc)[2][2][4][2], const Unit& u, int wr, int wc, int fr, int fq) const {
        store_tile_qk(acc, u.pn < 2 ? Q : Kb, u.pm >> 4, gi, 4 * (u.pn & 1), (u.pm & 15) * 256, wr, wc, fr, fq);
    }
};
struct EpiVt2 {
    static constexpr bool PERM = true, MID = false, AFTER = false;
    bf16_t* V; int gi;
    __device__ __forceinline__ void operator()(const f32x4 (&acc)[2][2][4][2], const Unit& u, int wr, int wc, int fr, int fq) const {
        const int b = u.pn >> 4, pos0 = (u.pn & 15) * 256;
#pragma unroll
        for (int ai = 0; ai < 2; ++ai)
#pragma unroll
            for (int m = 0; m < 4; ++m) { const int ch = u.pm * BM + ai * HALF + wr * 64 + m * 16 + fr, h = ch >> 6, d = ch & 63;
#pragma unroll
                for (int bj = 0; bj < 2; ++bj) { const int pos = pos0 + bj * HALF + wc * 32 + 8 * fq;
                    __builtin_nontemporal_store(pack8(acc[ai][bj][m][0], acc[ai][bj][m][1]), (u32x4*)(V + ((((size_t)(gi * 8 + h) * 8 + b) * (SEQ / 8) + (pos >> 3)) * 64 + d) * 8)); } }
    }
};
struct EpiPlain {
    static constexpr bool PERM = true, MID = false, AFTER = false;
    bf16_t* O; int ld;
    __device__ __forceinline__ void operator()(const f32x4 (&acc)[2][2][4][2], const Unit& u, int wr, int wc, int fr, int fq) const {
        store_tile_bf16(acc, O, ld, u.pm * BM + wr * 64 + fr, u.pn * BM + wc * 32 + 8 * fq);
    }
};
struct EpiGlu {
    static constexpr bool PERM = true, MID = false, AFTER = false;
    const bf16_t* YG; const bf16_t* ZS; const float* bglu; bf16_t* Y2;
    __device__ __forceinline__ void operator()(const f32x4 (&acc)[2][2][4][2], const Unit& u, int wr, int wc, int fr, int fq) const {
        const int row0 = u.pm * BM + wr * 64 + fr, col0 = u.pn * BM + wc * 32 + 8 * fq;
        f32x4 bv[2][2];
#pragma unroll
        for (int bj = 0; bj < 2; ++bj) { bv[bj][0] = *(const f32x4*)(bglu + col0 + bj * HALF); bv[bj][1] = *(const f32x4*)(bglu + col0 + bj * HALF + 4); }
#pragma unroll
        for (int ai = 0; ai < 2; ++ai)
#pragma unroll
            for (int m = 0; m < 4; ++m) { const size_t off = (size_t)(row0 + ai * HALF + m * 16) * SW + col0;
#pragma unroll
                for (int bj = 0; bj < 2; ++bj) {
                    f32x4 y0, y1, z0, z1; unpack8(*(const u32x4*)(YG + off + bj * HALF), y0, y1); unpack8(__builtin_nontemporal_load((const u32x4*)(ZS + (size_t)(u.pm * 2 + u.pn) * 65536 + tp_off(wr, wc, ai, m, bj, fr + 16 * fq))), z0, z1);
                    f32x4 v0 = acc[ai][bj][m][0] + bv[bj][0], v1 = acc[ai][bj][m][1] + bv[bj][1], o0, o1;
#pragma unroll
                    for (int j = 0; j < 4; ++j) { o0[j] = y0[j] * sigmoidf_(v0[j]) * siluf_(z0[j]); o1[j] = y1[j] * sigmoidf_(v1[j]) * siluf_(z1[j]); }
                    *(u32x4*)(Y2 + (size_t)(row0 + ai * HALF + m * 16) * (2 * AW) + AW + col0 + bj * HALF) = pack8(o0, o1); } }
    }
};
struct EpiMerge {
    static constexpr bool PERM = true, MID = true, AFTER = false;
    const bf16_t* GL; bf16_t* MG;
    __device__ __forceinline__ void mid(f32x4 (&acc)[2][2][4][2], const Unit& u, int wr, int wc, int fr, int fq) const {
        asm volatile("" : "+v"(fr), "+v"(fq));
        const int lane = fr + 16 * fq;
#pragma unroll
        for (int ai = 0; ai < 2; ++ai)
#pragma unroll
            for (int m = 0; m < 4; ++m)
#pragma unroll
                for (int bj = 0; bj < 2; ++bj) {
                    f32x4 r0, r1; unpack8(__builtin_nontemporal_load((const u32x4*)(GL + (size_t)(u.pm * 8 + 2 * u.pn + bj) * 32768 + (size_t)((((wr * 4 + wc) * 2 + ai) * 4 + m) * 512 + lane * 8))), r0, r1);
                    acc[ai][bj][m][0] = acc[ai][bj][m][0] * r0; acc[ai][bj][m][1] = acc[ai][bj][m][1] * r1; }
    }
    __device__ __forceinline__ void operator()(const f32x4 (&acc)[2][2][4][2], const Unit& u, int wr, int wc, int fr, int fq) const {
        const int row0 = u.pm * BM + wr * 64 + fr, col0 = u.pn * BM + wc * 32 + 8 * fq, lane = fr + 16 * fq;
        const bf16_t* gb = GL + (size_t)(MT / 256) * 8 * 32768;
#pragma unroll
        for (int ai = 0; ai < 2; ++ai)
#pragma unroll
            for (int m = 0; m < 4; ++m) { const size_t row = (size_t)(row0 + ai * HALF + m * 16);
#pragma unroll
                for (int bj = 0; bj < 2; ++bj) { const int col = col0 + bj * HALF;
                    f32x4 g0, g1; unpack8(__builtin_nontemporal_load((const u32x4*)(gb + (size_t)(u.pm * 8 + 2 * u.pn + bj) * 32768 + (size_t)((((wr * 4 + wc) * 2 + ai) * 4 + m) * 512 + lane * 8))), g0, g1);
                    *(u32x4*)(MG + row * DM + col) = pack8(g0 * acc[ai][bj][m][0], g1 * acc[ai][bj][m][1]); } }
    }
};
struct EpiLnOut {
    static constexpr bool PERM = true, MID = false, AFTER = true;
    const float* X; float* O; const float* lg; const float* lb; float* stats; unsigned* cnt; int row_base, panel_base;
    __device__ __forceinline__ void operator()(const f32x4 (&)[2][2][4][2], const Unit&, int, int, int, int) const {}
    __device__ __forceinline__ void after(f32x4 (&acc)[2][2][4][2], const Unit& u, int wr, int wc, int fr, int fq, LAS unsigned char* lds) const {
        const int tid = opaque_tid();
        asm volatile("" : "+v"(fr), "+v"(fq));
        const int row0 = row_base + u.pm * BM + wr * 64 + fr, col0 = u.pn * BM + wc * 32 + 8 * fq;
        LAS float* red = (LAS float*)lds;
        LAS float* mr = red + 2048;
#pragma unroll
        for (int ai = 0; ai < 2; ++ai)
#pragma unroll
            for (int m = 0; m < 4; ++m) { float s = 0.f, q = 0.f;
#pragma unroll
                for (int bj = 0; bj < 2; ++bj) { const float* xp = X + (size_t)(row0 + ai * HALF + m * 16) * DM + col0 + bj * HALF;
                    const f32x4 x0 = __builtin_nontemporal_load((const f32x4*)xp), x1 = __builtin_nontemporal_load((const f32x4*)(xp + 4));
                    f32x4 v0 = x0 * DN_ALPHA + acc[ai][bj][m][0], v1 = x1 * DN_ALPHA + acc[ai][bj][m][1];
                    acc[ai][bj][m][0] = v0; acc[ai][bj][m][1] = v1;
                    s += ((v0[0] + v0[1]) + (v0[2] + v0[3])) + ((v1[0] + v1[1]) + (v1[2] + v1[3]));
                    q += ((v0[0] * v0[0] + v0[1] * v0[1]) + (v0[2] * v0[2] + v0[3] * v0[3])) + ((v1[0] * v1[0] + v1[1] * v1[1]) + (v1[2] * v1[2] + v1[3] * v1[3])); }
                s += __shfl_xor(s, 16); s += __shfl_xor(s, 32); q += __shfl_xor(q, 16); q += __shfl_xor(q, 32);
                if (fq == 0) { const int r = ai * HALF + wr * 64 + m * 16 + fr; red[(wc * 256 + r) * 2] = s; red[(wc * 256 + r) * 2 + 1] = q; } }
        __syncthreads();
        { const int r = tid >> 1, w = tid & 1;
          const float v = (red[(0 * 256 + r) * 2 + w] + red[(1 * 256 + r) * 2 + w]) + (red[(2 * 256 + r) * 2 + w] + red[(3 * 256 + r) * 2 + w]);
          float old = __hip_atomic_fetch_add(stats + (size_t)(row_base + u.pm * BM + r) * 2 + w, v, __ATOMIC_RELAXED, __HIP_MEMORY_SCOPE_AGENT);
          asm volatile("s_waitcnt vmcnt(0)" : "+v"(old) :: "memory"); }
        __syncthreads();
        if (tid == 0) {
            unsigned* c = cnt + (size_t)(panel_base + u.pm) * 64;
            (void)__hip_atomic_fetch_add(c, 1u, __ATOMIC_RELAXED, __HIP_MEMORY_SCOPE_AGENT);
            unsigned spins = 0;
            while (__hip_atomic_load(c, __ATOMIC_RELAXED, __HIP_MEMORY_SCOPE_AGENT) < 4u) { __builtin_amdgcn_s_sleep(1); if (++spins > (1u << 22)) break; }
        }
        __syncthreads();
        if (tid < 256) {
            const float a = __hip_atomic_load(stats + (size_t)(row_base + u.pm * BM + tid) * 2, __ATOMIC_RELAXED, __HIP_MEMORY_SCOPE_AGENT);
            const float q = __hip_atomic_load(stats + (size_t)(row_base + u.pm * BM + tid) * 2 + 1, __ATOMIC_RELAXED, __HIP_MEMORY_SCOPE_AGENT);
            const float mean = a * (1.f / DM), var = fmaxf(q * (1.f / DM) - mean * mean, 0.f);
            mr[tid * 2] = mean; mr[tid * 2 + 1] = 1.f / sqrtf(var + LN_EPS);
        }
        __syncthreads();
#pragma unroll
        for (int bj = 0; bj < 2; ++bj) { const int col = col0 + bj * HALF;
            const f32x4 g0 = *(const f32x4*)(lg + col), g1 = *(const f32x4*)(lg + col + 4), b0 = *(const f32x4*)(lb + col), b1 = *(const f32x4*)(lb + col + 4);
#pragma unroll
            for (int ai = 0; ai < 2; ++ai)
#pragma unroll
                for (int m = 0; m < 4; ++m) { const int r = ai * HALF + wr * 64 + m * 16 + fr; const float mean = mr[r * 2], rstd = mr[r * 2 + 1];
                    float* op = O + (size_t)(row0 + ai * HALF + m * 16) * DM + col;
                    *(f32x4*)op = (acc[ai][bj][m][0] - mean) * rstd * g0 + b0; *(f32x4*)(op + 4) = (acc[ai][bj][m][1] - mean) * rstd * g1 + b1; } }
        __syncthreads();
    }
};

struct P1Unit { int pm, pn, seg; };
struct P1Order {
    int G, c, rep;
    __device__ __forceinline__ bool next(int i, P1Unit& u) const {
        long L = (long)i * G + c; if (L >= 4096L * rep) return false;
        L %= 4096;
        int seg, base, nM, nN;
        if (L < 2304) { seg = 0; base = 0; nM = 128; nN = 18; } else if (L < 2816) { seg = 1; base = 2304; nM = 128; nN = 4; } else if (L < 3328) { seg = 2; base = 2816; nM = 128; nN = 4; }
        else { seg = 3 + (int)((L - 3328) >> 8); base = 3328 + 256 * (seg - 3); nM = 2; nN = 128; }
        const int nwg = nM * nN; int wgid = (int)L - base;
        { const int q = nwg / NXCD, rr = nwg % NXCD, xcd = wgid % NXCD, off = wgid / NXCD; wgid = (xcd < rr ? xcd * (q + 1) : rr * (q + 1) + (xcd - rr) * q) + off; }
        const int nig = WGM * nN, gid = wgid / nig, fm = gid * WGM, gsz = (nM - fm) < WGM ? (nM - fm) : WGM;
        u.pm = fm + ((wgid % nig) % gsz); u.pn = (wgid % nig) / gsz; u.seg = seg; return true;
    }
    static __device__ __forceinline__ int dil(int gi) { return gi == 0 ? 1 : gi == 1 ? 4 : 16; }
    static __device__ __forceinline__ size_t tok0(int t, int r) { const int b = t >> 4, q = t & 15, pos0 = q * 256, NS = SEQ / r, ph = pos0 / NS, n0 = pos0 % NS; return (size_t)(b * SEQ + n0 * r + ph); }
    static __device__ __forceinline__ int rsA(const P1Unit& u) { return u.seg == 1 ? 4 : u.seg == 2 ? 16 : 1; }
    static __device__ __forceinline__ int rsB(const P1Unit& u) { return u.seg == 4 ? 4 : u.seg == 5 ? 16 : 1; }
    static __device__ __forceinline__ int hmB(const P1Unit& u) { return (u.seg == 0 && u.pn >= 10) ? 8 : rsB(u); }
    static __device__ __forceinline__ const char* a_ptr(const P1Unit& u, const bf16_t* XB, const bf16_t* WIN) {
        if (u.seg == 0) return (const char*)XB + (size_t)u.pm * 256 * DM * 2;
        if (u.seg <= 2) return (const char*)XB + tok0(u.pm, dil(u.seg)) * DM * 2;
        return (const char*)WIN + (size_t)(2 * QKVW + (u.seg - 3) * 512 + u.pm * 256) * DM * 2;
    }
    static __device__ __forceinline__ const char* b_ptr(const P1Unit& u, const bf16_t* XB, const bf16_t* WIN) {
        if (u.seg == 0) { const int wrow = u.pn < 2 ? 256 * u.pn : u.pn < 4 ? QKVW + 256 * (u.pn - 2) : u.pn < 10 ? 3 * QKVW + 256 * (u.pn - 4) : 3 * QKVW + 1536 + 128 * (u.pn - 10);
            return (const char*)WIN + (size_t)wrow * DM * 2; }
        if (u.seg <= 2) { const int wrow = u.pn < 2 ? u.seg * 512 + 256 * u.pn : QKVW + u.seg * 512 + 256 * (u.pn - 2); return (const char*)WIN + (size_t)wrow * DM * 2; }
        return (const char*)XB + tok0(u.pn, dil(u.seg - 3)) * DM * 2;
    }
};
__device__ __forceinline__ void p1_voff(int tid, int rsa, int rsb, unsigned (&va)[2], unsigned (&vb)[2]) {
#pragma unroll
    for (int i = 0; i < 2; ++i) { int R, C; stage_rc(tid * 16 + i * 8192, R, C); const int Rb = (R & ~31) + perm32(R & 31);
        va[i] = (unsigned)(R * rsa * DM + C) * 2u; vb[i] = (unsigned)(Rb * rsb * DM + C) * 2u; }
}
constexpr int P1_TAB_OFF = 131072, P1_TAB_N = 72;
__device__ __forceinline__ bool p1_get(LAS unsigned char* lds, const P1Order& S, const bf16_t* XB, const bf16_t* WIN, int i, P1Unit& u, const char*& ap, const char*& bp) {
    if (i >= P1_TAB_N) { const bool ok = S.next(i, u); if (ok) { ap = P1Order::a_ptr(u, XB, WIN); bp = P1Order::b_ptr(u, XB, WIN); } return ok; }
    const LAS unsigned* e = (const LAS unsigned*)(lds + P1_TAB_OFF) + i * 16;
    const unsigned ok = (unsigned)__builtin_amdgcn_readfirstlane((int)e[0]);
    u.pm = __builtin_amdgcn_readfirstlane((int)e[1]); u.pn = __builtin_amdgcn_readfirstlane((int)e[2]); u.seg = __builtin_amdgcn_readfirstlane((int)e[3]);
    const unsigned long long a = ((unsigned long long)(unsigned)__builtin_amdgcn_readfirstlane((int)e[5]) << 32) | (unsigned)__builtin_amdgcn_readfirstlane((int)e[4]);
    const unsigned long long b = ((unsigned long long)(unsigned)__builtin_amdgcn_readfirstlane((int)e[7]) << 32) | (unsigned)__builtin_amdgcn_readfirstlane((int)e[6]);
    ap = (const char*)a; bp = (const char*)b;
    return ok != 0u;
}
__device__ __forceinline__ void gemm_phase_p1(LAS unsigned char* lds, const bf16_t* XB, const bf16_t* WIN, unsigned char* ws, bf16_t* GL, const P1Order& S) {
    const int tid = opaque_tid(), wid = __builtin_amdgcn_readfirstlane(tid >> 6), lane = tid & 63, wr = wid >> 2, wc = wid & 3, fr = lane & 15, fq = lane >> 4;
    constexpr int K = DM, nt = K / BK;
    const size_t kstep = (size_t)(BK * 2);
    const size_t hunit = (size_t)HALF * K * 2;
    const unsigned ldsw = (unsigned)wid * 1024u;
    const int aoff = lds_byte(wr * 64 + fr, fq * 8), boff = lds_byte(wc * 32 + fr, fq * 8);
#define PG8_SA(b, h) (((b) * 2 + (h)) * HTB)
#define PG8_SB(b, h) ((4 + (b) * 2 + (h)) * HTB)
#define PG8_STAGE(bufoff, gbase, voff) do { _Pragma("unroll") for (int _i = 0; _i < 2; ++_i) \
        __builtin_amdgcn_global_load_lds((const unsigned*)((const char*)(gbase) + (voff)[_i]), (LAS unsigned*)(lds + (bufoff) + ldsw + _i * 8192), 16, 0, 0); } while (0)
#define PG8_LDA(dst, b, h) do { _Pragma("unroll") for (int m = 0; m < 4; ++m) _Pragma("unroll") for (int k = 0; k < 2; ++k) dst[m][k] = *(const LAS bf16x8*)(lds + PG8_SA(b, h) + aoff + m * 2048 + k * 1024); } while (0)
#define PG8_LDB(dst, b, h) do { _Pragma("unroll") for (int n = 0; n < 2; ++n) _Pragma("unroll") for (int k = 0; k < 2; ++k) dst[n][k] = *(const LAS bf16x8*)(lds + PG8_SB(b, h) + boff + n * 2048 + k * 1024); } while (0)
#define PG8_MMA(ai, bj, At, Bt) do { __builtin_amdgcn_s_setprio(1); _Pragma("unroll") for (int m = 0; m < 4; ++m) _Pragma("unroll") for (int n = 0; n < 2; ++n) _Pragma("unroll") for (int k = 0; k < 2; ++k) \
        acc[ai][bj][m][n] = __builtin_amdgcn_mfma_f32_16x16x32_bf16(Bt[n][k], At[m][k], acc[ai][bj][m][n], 0, 0, 0); __builtin_amdgcn_s_setprio(0); } while (0)
#define PG8_WAIT_V(n) asm volatile("s_waitcnt vmcnt(" #n ")" ::: "memory")
#define PG8_WAIT_L(n) asm volatile("s_waitcnt lgkmcnt(" #n ")" ::: "memory")
#define PG8_BAR __builtin_amdgcn_s_barrier()
#define PG8_SCHED __builtin_amdgcn_sched_barrier(0)
    {
        LAS unsigned* tab = (LAS unsigned*)(lds + P1_TAB_OFF);
        for (int i = tid; i < P1_TAB_N; i += 512) { P1Unit u; const bool ok = S.next(i, u); if (!ok) { u.pm = 0; u.pn = 0; u.seg = 0; }
            const unsigned long long a = (unsigned long long)P1Order::a_ptr(u, XB, WIN), b = (unsigned long long)P1Order::b_ptr(u, XB, WIN);
            tab[i * 16 + 0] = ok ? 1u : 0u; tab[i * 16 + 1] = (unsigned)u.pm; tab[i * 16 + 2] = (unsigned)u.pn; tab[i * 16 + 3] = (unsigned)u.seg;
            tab[i * 16 + 4] = (unsigned)a; tab[i * 16 + 5] = (unsigned)(a >> 32); tab[i * 16 + 6] = (unsigned)b; tab[i * 16 + 7] = (unsigned)(b >> 32); }
        __syncthreads();
    }
    P1Unit cur, nxt; int ui = 0;
    const char* cA; const char* cB;
    if (!p1_get(lds, S, XB, WIN, 0, cur, cA, cB)) return;
    f32x4 acc[2][2][4][2];
#pragma unroll
    for (int a = 0; a < 2; ++a)
#pragma unroll
        for (int b = 0; b < 2; ++b)
#pragma unroll
            for (int m = 0; m < 4; ++m)
#pragma unroll
                for (int n = 0; n < 2; ++n) acc[a][b][m][n] = (f32x4){0.f, 0.f, 0.f, 0.f};
    bf16x8 At[4][2], B0[2][2], B1[2][2];
    unsigned vAc[2], vBc[2], vAn[2], vBn[2];
    p1_voff(tid, P1Order::rsA(cur), P1Order::rsB(cur), vAc, vBc);
    size_t hAc = hunit * P1Order::rsA(cur), hBc = hunit * P1Order::hmB(cur);
    PG8_STAGE(PG8_SB(0, 0), cB, vBc); PG8_STAGE(PG8_SB(0, 1), cB + hBc, vBc); PG8_STAGE(PG8_SA(0, 0), cA, vAc); PG8_STAGE(PG8_SA(0, 1), cA + hAc, vAc);
    if (wr == 1) PG8_BAR;
    PG8_WAIT_V(2); PG8_BAR;
    PG8_STAGE(PG8_SB(1, 0), cB + kstep, vBc); PG8_STAGE(PG8_SA(1, 0), cA + kstep, vAc); PG8_STAGE(PG8_SB(1, 1), cB + hBc + kstep, vBc);
    PG8_WAIT_V(6); PG8_BAR;
    for (;;) {
        const char* nA = cA; const char* nB = cB;
        const bool has_next = p1_get(lds, S, XB, WIN, ui + 1, nxt, nA, nB);
        if (!has_next) { nxt = cur; nA = cA; nB = cB; }
        p1_voff(tid, P1Order::rsA(nxt), P1Order::rsB(nxt), vAn, vBn);
        const size_t hAn = hunit * P1Order::rsA(nxt), hBn = hunit * P1Order::hmB(nxt);
        for (int t = 0; t < nt; t += 2) {
            const bool last = (t == nt - 2);
            const char* a1 = cA + (size_t)(t + 1) * kstep;
            const char* a2 = last ? nA : cA + (size_t)(t + 2) * kstep; const char* b2 = last ? nB : cB + (size_t)(t + 2) * kstep;
            const char* a3 = a2 + kstep; const char* b3 = b2 + kstep;
            unsigned vA2[2], vB2[2];
            vA2[0] = last ? vAn[0] : vAc[0]; vA2[1] = last ? vAn[1] : vAc[1]; vB2[0] = last ? vBn[0] : vBc[0]; vB2[1] = last ? vBn[1] : vBc[1];
            const size_t hA2 = last ? hAn : hAc, hB2 = last ? hBn : hBc;
            PG8_LDB(B0, 0, 0); PG8_LDB(B1, 0, 1); PG8_SCHED; PG8_LDA(At, 0, 0); PG8_STAGE(PG8_SA(1, 1), a1 + hAc, vAc);
            PG8_WAIT_V(8); PG8_WAIT_L(0); PG8_BAR; PG8_MMA(0, 0, At, B0); PG8_MMA(0, 1, At, B1); PG8_BAR; PG8_SCHED;
            PG8_LDA(At, 0, 1); PG8_STAGE(PG8_SB(0, 0), b2, vB2); PG8_STAGE(PG8_SB(0, 1), b2 + hB2, vB2); PG8_STAGE(PG8_SA(0, 0), a2, vA2);
            PG8_WAIT_V(8); PG8_WAIT_L(0); PG8_BAR; PG8_MMA(1, 0, At, B0); PG8_MMA(1, 1, At, B1); PG8_BAR; PG8_SCHED;
            PG8_LDB(B0, 1, 0); PG8_LDB(B1, 1, 1); PG8_SCHED; PG8_LDA(At, 1, 0); PG8_STAGE(PG8_SA(0, 1), a2 + hA2, vA2);
            PG8_WAIT_V(8); PG8_WAIT_L(0); PG8_BAR; PG8_MMA(0, 0, At, B0); PG8_MMA(0, 1, At, B1); PG8_BAR; PG8_SCHED;
            PG8_LDA(At, 1, 1); PG8_STAGE(PG8_SB(1, 0), b3, vB2); PG8_STAGE(PG8_SB(1, 1), b3 + hB2, vB2); PG8_STAGE(PG8_SA(1, 0), a3, vA2);
            PG8_WAIT_V(8); PG8_WAIT_L(0); PG8_BAR; PG8_MMA(1, 0, At, B0); PG8_MMA(1, 1, At, B1); PG8_BAR; PG8_SCHED;
        }
        {
            const Unit uu{cur.pm, cur.pn};
            if (cur.seg == 0) { const EpiProj E{ws, GL}; E(acc, uu, wr, wc, fr, fq); }
            else if (cur.seg <= 2) { const EpiQK E{(bf16_t*)(ws + WS_Q), (bf16_t*)(ws + WS_K), cur.seg}; E(acc, uu, wr, wc, fr, fq); }
            else { const EpiVt2 E{(bf16_t*)(ws + WS_VT), cur.seg - 3}; E(acc, uu, wr, wc, fr, fq); }
        }
        if (!has_next) break;
#pragma unroll
        for (int a = 0; a < 2; ++a)
#pragma unroll
            for (int b = 0; b < 2; ++b)
#pragma unroll
                for (int m = 0; m < 4; ++m)
#pragma unroll
                    for (int n = 0; n < 2; ++n) acc[a][b][m][n] = (f32x4){0.f, 0.f, 0.f, 0.f};
        cur = nxt; cA = nA; cB = nB; ++ui;
        vAc[0] = vAn[0]; vAc[1] = vAn[1]; vBc[0] = vBn[0]; vBc[1] = vBn[1]; hAc = hAn; hBc = hBn;
    }
    PG8_WAIT_V(0);
    if (wr == 0) PG8_BAR;
    PG8_BAR;
#undef PG8_SA
#undef PG8_SB
#undef PG8_STAGE
#undef PG8_LDA
#undef PG8_LDB
#undef PG8_MMA
#undef PG8_WAIT_V
#undef PG8_WAIT_L
#undef PG8_BAR
#undef PG8_SCHED
}
}

__device__ __forceinline__ void p0_transpose_item(const float* W, int K, int N, bf16_t* WT, LAS float* scr, int item, int lane, int ldt = 0, int koff = 0) {
    if (ldt == 0) ldt = K;
    const int nblk = N / 32, kb = item / nblk, nb = item % nblk, k0 = 64 * kb, n0 = 32 * nb;
#pragma unroll 8
    for (int i = 0; i < 32; ++i) { const int kk = 2 * i + (lane >> 5); scr[kk * 33 + (lane & 31)] = W[(size_t)(k0 + kk) * N + n0 + (lane & 31)]; }
    asm volatile("s_waitcnt lgkmcnt(0)" ::: "memory");
    const int c = lane & 7;
#pragma unroll
    for (int j = 0; j < 4; ++j) { const int n = (lane >> 3) + 8 * j; const LAS float* s = scr + (8 * c) * 33 + n;
        u32x4 o; o.x = cvt_pk_bf16(s[0 * 33], s[1 * 33]); o.y = cvt_pk_bf16(s[2 * 33], s[3 * 33]); o.z = cvt_pk_bf16(s[4 * 33], s[5 * 33]); o.w = cvt_pk_bf16(s[6 * 33], s[7 * 33]);
        *(u32x4*)(WT + (size_t)(n0 + n) * ldt + koff + k0 + 8 * c) = o; }
    asm volatile("s_waitcnt lgkmcnt(0)" ::: "memory");
}

__device__ __forceinline__ void sincos_d(double th, double& s, double& c) {
    const double k = rint(th * 0.63661977236758134308);
    const double r = fma(-k, 6.123233995736766e-17, fma(-k, 1.5707963267948966, th));
    const double r2 = r * r;
    double sp = 1.0 / 6227020800.0;
    sp = fma(sp, r2, -1.0 / 39916800.0); sp = fma(sp, r2, 1.0 / 362880.0); sp = fma(sp, r2, -1.0 / 5040.0); sp = fma(sp, r2, 1.0 / 120.0); sp = fma(sp, r2, -1.0 / 6.0); sp = fma(sp, r2, 1.0);
    const double sn = sp * r;
    double cp = -1.0 / 87178291200.0;
    cp = fma(cp, r2, 1.0 / 479001600.0); cp = fma(cp, r2, -1.0 / 3628800.0); cp = fma(cp, r2, 1.0 / 40320.0); cp = fma(cp, r2, -1.0 / 720.0); cp = fma(cp, r2, 1.0 / 24.0); cp = fma(cp, r2, -0.5); cp = fma(cp, r2, 1.0);
    const int q = ((int)k) & 3;
    s = (q == 0) ? sn : (q == 1) ? cp : (q == 2) ? -sn : -cp;
    c = (q == 0) ? cp : (q == 1) ? -sn : (q == 2) ? -cp : sn;
}
__device__ __forceinline__ double exp_small_d(double z) {
    const double y = z * (1.0 / 64.0);
    double p = 1.0 / 40320.0; p = fma(p, y, 1.0 / 5040.0); p = fma(p, y, 1.0 / 720.0); p = fma(p, y, 1.0 / 120.0); p = fma(p, y, 1.0 / 24.0); p = fma(p, y, 1.0 / 6.0); p = fma(p, y, 0.5); p = fma(p, y, 1.0); p = fma(p, y, 1.0);
#pragma unroll
    for (int i = 0; i < 6; ++i) p = p * p;
    return p;
}

struct Params { const float* in[17]; float* out; unsigned char* ws; };

constexpr int CH = 256;

__device__ __forceinline__ void phase0(const Params& p, LAS unsigned char* lds, int G) {
    const int tid = opaque_tid(), lane = tid & 63, wave = tid >> 6;
    const int gw = blockIdx.x * 8 + wave, NGW = G * 8;
    unsigned char* ws = p.ws;
    {
        const float* x = p.in[0]; bf16_t* xb = (bf16_t*)(ws + WS_XB);
        const size_t n8 = (size_t)MT * DM / 8, stride = (size_t)G * 512;
        for (size_t i = (size_t)blockIdx.x * 512 + tid; i < n8; i += stride) {
            const f32x4 a = __builtin_nontemporal_load((const f32x4*)(x + i * 8)), b = __builtin_nontemporal_load((const f32x4*)(x + i * 8 + 4));
            *(u32x4*)(xb + i * 8) = pg8::pack8(a, b);
        }
    }
    {
        LAS float* scr = (LAS float*)(lds + wave * 16384);
        constexpr int I_IN = (DM / 64) * (DIN / 32), I_GLU = (SW / 64) * (SW / 32), I_AU = (AW / 64) * (DM / 32), I_SU = (SW / 64) * (DM / 32), I_O = (DM / 64) * (DM / 32);
        constexpr int NIT = I_IN + I_GLU + I_AU + I_SU + I_O;
        for (int it = gw; it < NIT; it += NGW) {
            int r = it;
            if (r < I_IN) { p0_transpose_item(p.in[1], DM, DIN, (bf16_t*)(ws + WS_WIN), scr, r, lane); continue; } r -= I_IN;
            if (r < I_GLU) { p0_transpose_item(p.in[10], SW, SW, (bf16_t*)(ws + WS_WGLU), scr, r, lane); continue; } r -= I_GLU;
            if (r < I_AU) { p0_transpose_item(p.in[12], AW, DM, (bf16_t*)(ws + WS_WUP), scr, r, lane, 2 * AW, 0); continue; } r -= I_AU;
            if (r < I_SU) { p0_transpose_item(p.in[13], SW, DM, (bf16_t*)(ws + WS_WUP), scr, r, lane, 2 * AW, AW); continue; } r -= I_SU;
            p0_transpose_item(p.in[14], DM, DM, (bf16_t*)(ws + WS_WO), scr, r, lane);
        }
    }
    {
        const int gt = blockIdx.x * 512 + tid;
        if (gt < SG * SP) {
            const int g = gt / SP;
            float* sp = (float*)(ws + WS_SSMP);
            const double lr = (double)p.in[2][gt], li = (double)p.in[3][gt];
            const double dt = exp_small_d((double)p.in[4][g]);
            const double mag = exp_small_d(lr * dt);
            double sn, cs; sincos_d(li * dt, sn, cs);
            const double abr = mag * cs, abi = mag * sn;
            const double nr = abr - 1.0, ni = abi, den = lr * lr + li * li;
            const double cr = (nr * lr + ni * li) / den, ci = (ni * lr - nr * li) / den;
            sp[SPF_A + gt * 2] = (float)abr; sp[SPF_A + gt * 2 + 1] = (float)abi;
            const double magc = exp_small_d(lr * dt * CH); double snc, csc; sincos_d(li * dt * CH, snc, csc);
            sp[SPF_ACH + gt * 2] = (float)(magc * csc); sp[SPF_ACH + gt * 2 + 1] = (float)(magc * snc);
            const float* br = p.in[5] + (size_t)gt * SC; const float* bi = p.in[6] + (size_t)gt * SC;
            for (int c = 0; c < SC; ++c) {
                const double b_r = br[c], b_i = bi[c];
                sp[SPF_BBR + gt * SC + c] = (float)(cr * b_r - ci * b_i);
                sp[SPF_BBI + gt * SC + c] = (float)(cr * b_i + ci * b_r);
            }
            {
                double pr = abr, pi = abi;
                for (int s = 0; s < 4; ++s) { const double nr2 = pr * pr - pi * pi, ni2 = 2.0 * pr * pi; pr = nr2; pi = ni2; }
                sp[SPF_A16 + gt * 2] = (float)pr; sp[SPF_A16 + gt * 2 + 1] = (float)pi;
            }
        }
    }
    {
        bf16_t* w16r = (bf16_t*)(ws + WS_W16R); bf16_t* w16i = (bf16_t*)(ws + WS_W16I);
        for (int it = blockIdx.x * 512 + tid; it < SG * SP * 16; it += G * 512) {
            const int gp = it >> 4, kk = it & 15, g = gp / SP, pl = gp % SP;
            const double lr = (double)p.in[2][gp], li = (double)p.in[3][gp];
            const double dt = exp_small_d((double)p.in[4][g]);
            const double mag = exp_small_d(lr * dt);
            double sn, cs; sincos_d(li * dt, sn, cs);
            const double abr = mag * cs, abi = mag * sn;
            const double nr = abr - 1.0, ni = abi, den = lr * lr + li * li;
            const float cr = (float)((nr * lr + ni * li) / den), ci = (float)((ni * lr - nr * li) / den);
            float pr = 1.f, pi = 0.f; const float far = (float)abr, fai = (float)abi;
            for (int s = 0; s < 15 - kk; ++s) { const float n1 = pr * far - pi * fai, n2 = pr * fai + pi * far; pr = n1; pi = n2; }
            const float wr_ = pr * cr - pi * ci, wi_ = pr * ci + pi * cr;
            const float* br = p.in[5] + (size_t)gp * SC; const float* bi = p.in[6] + (size_t)gp * SC;
            bf16_t* dr = w16r + ((size_t)((g * 16 + kk) * SP + pl)) * SC; bf16_t* di = w16i + ((size_t)((g * 16 + kk) * SP + pl)) * SC;
#pragma unroll
            for (int c = 0; c < SC; c += 2) {
                *(unsigned*)(dr + c) = cvt_pk_bf16(wr_ * br[c] - wi_ * bi[c], wr_ * br[c + 1] - wi_ * bi[c + 1]);
                *(unsigned*)(di + c) = cvt_pk_bf16(wr_ * bi[c] + wi_ * br[c], wr_ * bi[c + 1] + wi_ * br[c + 1]);
            }
        }
    }
}

struct AttnStep { int b, h, T0, g, lr, ph, jq, n0; };
__device__ __forceinline__ AttnStep attn_decode(int s, int vcu, int G, int wave) {
    AttnStep a; const int it = s / 6, rem = s - it * 6, item = vcu + it * G;
    a.b = item >> 6; a.h = (item >> 3) & 7; a.T0 = (item & 7) * 512; a.g = rem >> 1; a.lr = 2 * a.g;
    const int qi = wave * 2 + (rem & 1);
    a.ph = qi >> (4 - a.lr); a.jq = qi & ((16 >> a.lr) - 1); a.n0 = (a.T0 >> a.lr) + 32 * a.jq;
    return a;
}
__device__ __forceinline__ void attn_load_qk(const AttnStep& a, const bf16_t* Q, const bf16_t* Kb, int lane, bf16x8 (&qf)[4], bf16x8 (&kf)[5][4]) {
    int lq = lane; asm volatile("" : "+v"(lq));
    const int n = lq & 31, hh = lq >> 5;
    const int kperm = (n & 19) | ((n & 4) << 1) | ((n & 8) >> 1);
    const int p0 = a.ph * (SEQ >> a.lr);
    const bf16_t* qp = Q + pg8::qk_addr(a.b, a.g, a.h, hh, p0 + a.n0) + (size_t)n * 8;
#pragma unroll
    for (int kk = 0; kk < 4; ++kk) qf[kk] = __builtin_nontemporal_load((const bf16x8*)(qp + (size_t)kk * 2 * 32 * 8));
#pragma unroll
    for (int j = 0; j < 5; ++j) {
        const int nk0 = a.n0 - 128 + 32 * j, nkc = nk0 < 0 ? 0 : nk0;
        const bf16_t* kp = Kb + pg8::qk_addr(a.b, a.g, a.h, hh, p0 + nkc) + (size_t)kperm * 8;
#pragma unroll
        for (int kk = 0; kk < 4; ++kk) kf[j][kk] = *(const bf16x8*)(kp + (size_t)kk * 2 * 32 * 8);
    }
}
__device__ __forceinline__ void lds_wait_ge(volatile LAS unsigned* c, unsigned target) {
    unsigned spins = 0;
    while (*c < target) { __builtin_amdgcn_s_sleep(1); if (++spins > (1u << 24)) break; }
    asm volatile("" ::: "memory");
}
__device__ __forceinline__ void lds_arrive(LAS unsigned* c, int lane) {
    asm volatile("s_waitcnt lgkmcnt(0)" ::: "memory");
    if (lane == 0) (void)__hip_atomic_fetch_add(c, 1u, __ATOMIC_RELAXED, __HIP_MEMORY_SCOPE_WORKGROUP);
}
__device__ __forceinline__ void attn_phase(const Params& p, LAS unsigned char* lds, int G) {
    const int tid = opaque_tid(), lane = tid & 63, wave = __builtin_amdgcn_readfirstlane(tid >> 6);
    unsigned char* ws = p.ws;
    const bf16_t* Q = (const bf16_t*)(ws + WS_Q); const bf16_t* Kb = (const bf16_t*)(ws + WS_K); const bf16_t* Vt = (const bf16_t*)(ws + WS_VT);
    const bf16_t* ZA = (const bf16_t*)(ws + WS_ZA); bf16_t* AT = (bf16_t*)(ws + WS_AT2);
    LAS float* Obuf = (LAS float*)lds; LAS float* mbuf = (LAS float*)(lds + 131072); LAS float* lbuf = mbuf + 512;
    const float LOG2E = 1.4426950408889634f, NINF = -__builtin_inff();
    const float c1 = 0.125f * LOG2E;
    const int vcu = (G % 8 == 0) ? (int)(blockIdx.x & 7) * (G >> 3) + (int)(blockIdx.x >> 3) : (int)blockIdx.x;
    const int nitems = (512 - vcu + G - 1) / G, nsteps = nitems * 6;
    if (nsteps <= 0) return;
    LAS unsigned* cntR = (LAS unsigned*)(lds + LDS_BYTES - 64);
    LAS unsigned* cntF = cntR + 1;
    if (tid == 0) { cntR[0] = 0u; cntF[0] = 0u; }
    __syncthreads();
    bf16x8 qf[4], kf[5][4];
    { const AttnStep a0 = attn_decode(0, vcu, G, wave); attn_load_qk(a0, Q, Kb, lane, qf, kf); }
#pragma unroll 1
    for (int s = 0; s < nsteps; ++s) {
        const AttnStep a = attn_decode(s, vcu, G, wave);
        const int b = a.b, h = a.h, T0 = a.T0, g = a.g, lr = a.lr, r = 1 << lr, NS = SEQ >> lr, ph = a.ph, jq = a.jq, n0 = a.n0;
        int lq = lane; asm volatile("" : "+v"(lq));
        const int n = lq & 31, hh = lq >> 5;
        const int th0 = n - 8 * hh;
        const float c2 = exp2f(-(float)(h + 1)) * LOG2E * (float)r;
        const float sbase = -c2 * (float)(128 + th0);
        f32x16 S[5];
#pragma unroll
        for (int j = 0; j < 5; ++j)
#pragma unroll
            for (int i = 0; i < 16; ++i) S[j][i] = 0.f;
#pragma unroll
        for (int kk = 0; kk < 4; ++kk)
#pragma unroll
            for (int j = 0; j < 5; ++j) S[j] = MFMA32(kf[j][kk], qf[kk], S[j]);
        __builtin_amdgcn_sched_barrier(0);
        const bf16_t* vp = Vt + ((((size_t)(g * 8 + h) * 8 + b) * (SEQ / 8) + ((ph * NS) >> 3) + hh) * 64 + n) * 8;
        bf16x8 vf[5][2][2];
#pragma unroll
        for (int j = 0; j < 3; ++j) {
            const int nk0 = n0 - 128 + 32 * j, nkc = nk0 < 0 ? 0 : nk0;
#pragma unroll
            for (int m = 0; m < 2; ++m) { vf[j][m][0] = *(const bf16x8*)(vp + (size_t)((nkc >> 3) + 2 * m) * 512); vf[j][m][1] = *(const bf16x8*)(vp + (size_t)((nkc >> 3) + 2 * m) * 512 + 256); }
        }
        __builtin_amdgcn_sched_barrier(0);
        float mx = NINF;
#pragma unroll
        for (int j = 0; j < 5; ++j) {
            const float sbj = (n0 - 128 + 32 * j) >= 0 ? sbase : NINF;
#pragma unroll
            for (int i = 0; i < 16; ++i) {
                const int ce = 16 * (i >> 3) + (i & 7);
                float sc = fmaf(S[j][i], c1, fmaf(c2, (float)(32 * j + ce), sbj));
                if (j == 0) sc = (ce >= th0) ? sc : NINF;
                if (j == 4) sc = (ce <= th0) ? sc : NINF;
                S[j][i] = sc; mx = fmaxf(mx, sc);
            }
        }
        mx = fmaxf(mx, __shfl_xor(mx, 32));
        float ls = 0.f; bf16x8 pf[5][2];
#pragma unroll
        for (int j = 0; j < 5; ++j)
#pragma unroll
            for (int m = 0; m < 2; ++m) { u32x4 w;
#pragma unroll
                for (int q4 = 0; q4 < 4; ++q4) { const float p0 = __builtin_amdgcn_exp2f(S[j][8 * m + 2 * q4] - mx), p1 = __builtin_amdgcn_exp2f(S[j][8 * m + 2 * q4 + 1] - mx);
                    ls += p0 + p1; w[q4] = cvt_pk_bf16(p0, p1); }
                pf[j][m] = __builtin_bit_cast(bf16x8, w); }
        ls += __shfl_xor(ls, 32);
        __builtin_amdgcn_sched_barrier(0);
#pragma unroll
        for (int j = 3; j < 5; ++j) {
            const int nk0 = n0 - 128 + 32 * j, nkc = nk0 < 0 ? 0 : nk0;
#pragma unroll
            for (int m = 0; m < 2; ++m) { vf[j][m][0] = *(const bf16x8*)(vp + (size_t)((nkc >> 3) + 2 * m) * 512); vf[j][m][1] = *(const bf16x8*)(vp + (size_t)((nkc >> 3) + 2 * m) * 512 + 256); }
        }
        __builtin_amdgcn_sched_barrier(0);
        f32x16 O0, O1;
#pragma unroll
        for (int i = 0; i < 16; ++i) { O0[i] = 0.f; O1[i] = 0.f; }
#pragma unroll
        for (int j = 0; j < 5; ++j)
#pragma unroll
            for (int m = 0; m < 2; ++m) { O0 = MFMA32(vf[j][m][0], pf[j][m], O0); O1 = MFMA32(vf[j][m][1], pf[j][m], O1); }
        __builtin_amdgcn_sched_barrier(0);
        { const AttnStep an = attn_decode(s + 1 < nsteps ? s + 1 : s, vcu, G, wave); attn_load_qk(an, Q, Kb, lane, qf, kf); }
        __builtin_amdgcn_sched_barrier(0);
        const int itn = s / 6;
        if (g == 0) lds_wait_ge((volatile LAS unsigned*)cntF, 8u * (unsigned)itn); else lds_wait_ge((volatile LAS unsigned*)cntR, 8u * (unsigned)(6 * itn + 2 * g));
        const int row = (32 * jq + n) * r + ph;
        const int gsw = (row ^ (row >> 4)) & 15;
        float mo = NINF, lo_ = 0.f;
        if (g > 0) { mo = mbuf[row]; lo_ = lbuf[row]; }
        const float mn = fmaxf(mo, mx); const float al = __builtin_amdgcn_exp2f(mo - mn), be = __builtin_amdgcn_exp2f(mx - mn);
#pragma unroll
        for (int dt = 0; dt < 2; ++dt)
#pragma unroll
            for (int j4 = 0; j4 < 4; ++j4) {
                const int chunk = 8 * dt + 2 * j4 + hh;
                LAS f32x4* ptr = (LAS f32x4*)(Obuf + row * 64 + ((chunk ^ gsw) * 4));
                f32x4 o;
                if (dt == 0) o = (f32x4){O0[4 * j4], O0[4 * j4 + 1], O0[4 * j4 + 2], O0[4 * j4 + 3]}; else o = (f32x4){O1[4 * j4], O1[4 * j4 + 1], O1[4 * j4 + 2], O1[4 * j4 + 3]};
                o = o * be;
                if (g > 0) o += *ptr * al;
                *ptr = o;
            }
        if (hh == 0) { mbuf[row] = mn; lbuf[row] = lo_ * al + ls * be; }
        const int rem = s % 6;
        lds_arrive(cntR, lane);
        if (rem == 5) {
            lds_wait_ge((volatile LAS unsigned*)cntR, 48u * (unsigned)(itn + 1));
            u32x4 zz[8];
#pragma unroll
            for (int it = 0; it < 8; ++it) { const int idx = it * 512 + tid, row2 = idx >> 3, dc = idx & 7; zz[it] = __builtin_nontemporal_load((const u32x4*)(ZA + (size_t)(((b * 16 + ((T0 + row2) >> 8)) * 2 + (h >> 2))) * 65536
                    + pg8::tp_off((row2 >> 6) & 1, (h & 1) * 2 + (dc >> 2), (row2 >> 7) & 1, (row2 >> 4) & 3, (h >> 1) & 1, (row2 & 15) + 16 * (dc & 3)))); }
#pragma unroll
            for (int it = 0; it < 8; ++it) {
                const int idx = it * 512 + tid, row2 = idx >> 3, dc = idx & 7, gs2 = (row2 ^ (row2 >> 4)) & 15;
                const f32x4 a0 = *(const LAS f32x4*)(Obuf + row2 * 64 + (((2 * dc) ^ gs2) * 4)), a1 = *(const LAS f32x4*)(Obuf + row2 * 64 + (((2 * dc + 1) ^ gs2) * 4));
                const float inv = 1.f / lbuf[row2];
                f32x4 z0, z1; pg8::unpack8(zz[it], z0, z1);
                f32x4 o0, o1;
#pragma unroll
                for (int j = 0; j < 4; ++j) { o0[j] = a0[j] * inv * siluf_(z0[j]); o1[j] = a1[j] * inv * siluf_(z1[j]); }
                *(u32x4*)(AT + ((size_t)b * SEQ + T0 + row2) * (2 * AW) + h * 64 + 8 * dc) = pg8::pack8(o0, o1);
            }
            lds_arrive(cntF, lane);
        }
    }
    __syncthreads();
}

constexpr int XS_PITCH = 272, XS_WAVE = 32 * XS_PITCH;
#define MFMA16(a, b, c) __builtin_amdgcn_mfma_f32_16x16x32_bf16((a), (b), (c), 0, 0, 0)
__device__ __forceinline__ bf16x8 pack_bf8(f32x4 a, f32x4 b) { return __builtin_bit_cast(bf16x8, pg8::pack8(a, b)); }
__device__ __forceinline__ void ssm_pass1_fast(const Params& p, int G) {
    const int tid = opaque_tid(), lane = tid & 63, wave = __builtin_amdgcn_readfirstlane(tid >> 6);
    const int n = lane & 31, hh = lane >> 5;
    unsigned char* ws = p.ws;
    const float* sp = (const float*)(ws + WS_SSMP);
    const bf16_t* US = (const bf16_t*)(ws + WS_US);
    const bf16_t* w16r = (const bf16_t*)(ws + WS_W16R); const bf16_t* w16i = (const bf16_t*)(ws + WS_W16I);
    float* CHS = (float*)(ws + WS_CHST);
    unsigned* ssmc = (unsigned*)(ws + WS_SSMC);
    const int seqA = (n >> 2) & 1, tileA = 4 * (n >> 3) + (n & 3);
    unsigned njobs = 0;
    for (int job = blockIdx.x * 8 + wave; job < SG * 4 * (SEQ / CH); job += G * 8) {
        const int g = job & 31, pair = (job >> 5) & 3, chunk = job >> 7;
        ++njobs;
        if (chunk == SEQ / CH - 1) continue;
        const bf16_t* up = US + (size_t)((((pair + 4 * seqA) * 16 + chunk) * 2 + (g >> 4))) * 65536
                         + pg8::tp_off((tileA >> 2) & 1, (g >> 1) & 3, (tileA >> 3) & 1, tileA & 3, (g >> 3) & 1, 16 * ((g & 1) * 2 + hh));
        const bf16_t* wr_ = w16r + ((size_t)(g * 16) * SP + n) * SC + 8 * hh; const bf16_t* wi_ = w16i + ((size_t)(g * 16) * SP + n) * SC + 8 * hh;
        f32x16 aR[2], aI[2];
#pragma unroll
        for (int pt = 0; pt < 2; ++pt)
#pragma unroll
            for (int i = 0; i < 16; ++i) { aR[pt][i] = 0.f; aI[pt][i] = 0.f; }
#pragma unroll 4
        for (int kk = 0; kk < 16; ++kk) {
            const bf16x8 uf = *(const bf16x8*)(up + kk * 8);
#pragma unroll
            for (int pt = 0; pt < 2; ++pt) {
                const bf16x8 br = *(const bf16x8*)(wr_ + (size_t)(kk * SP + 32 * pt) * SC), bi = *(const bf16x8*)(wi_ + (size_t)(kk * SP + 32 * pt) * SC);
                aR[pt] = MFMA32(uf, br, aR[pt]); aI[pt] = MFMA32(uf, bi, aI[pt]);
            }
        }
        const int bme = pair + 4 * hh;
#pragma unroll
        for (int pt = 0; pt < 2; ++pt) {
            const int gp = g * SP + 32 * pt + n;
            const float ar = sp[SPF_A16 + gp * 2], ai = sp[SPF_A16 + gp * 2 + 1];
            float xr = 0.f, xi = 0.f;
#pragma unroll
            for (int i = 0; i < 16; ++i) { const float nr = fmaf(ar, xr, fmaf(-ai, xi, aR[pt][i])), ni = fmaf(ar, xi, fmaf(ai, xr, aI[pt][i])); xr = nr; xi = ni; }
            float* e = CHS + ((size_t)((bme * SG + g) * (SEQ / CH) + chunk) * SP + 32 * pt + n) * 2;
            __hip_atomic_store((unsigned long long*)e, __builtin_bit_cast(unsigned long long, (f32x2){xr, xi}), __ATOMIC_RELAXED, __HIP_MEMORY_SCOPE_AGENT);
        }
    }
    asm volatile("s_waitcnt vmcnt(0)" ::: "memory");
    if (lane == 0 && njobs) (void)__hip_atomic_fetch_add(ssmc, njobs, __ATOMIC_RELAXED, __HIP_MEMORY_SCOPE_AGENT);
}
template <int PASS>
__device__ __forceinline__ void ssm_pass(const Params& p, LAS unsigned char* lds, int G) {
    const int tid = opaque_tid(), lane = tid & 63, wave = __builtin_amdgcn_readfirstlane(tid >> 6);
    const int n = lane & 31, hh = lane >> 5;
    unsigned char* ws = p.ws;
    const float* sp = (const float*)(ws + WS_SSMP);
    const bf16_t* US = (const bf16_t*)(ws + WS_US); bf16_t* YG = (bf16_t*)(ws + WS_YG);
    float* CHS = (float*)(ws + WS_CHST);
    LAS unsigned char* xs = lds + wave * XS_WAVE;
    const int seqA = (n >> 2) & 1, qA = 4 * (n >> 3) + (n & 3);
    unsigned* ssmc = (unsigned*)(ws + WS_SSMC);
    if (PASS == 2) {
        unsigned spins = 0;
        while (__builtin_amdgcn_readfirstlane(__hip_atomic_load(ssmc, __ATOMIC_RELAXED, __HIP_MEMORY_SCOPE_AGENT)) < (unsigned)(SG * 4 * (SEQ / CH))) { __builtin_amdgcn_s_sleep(2); if (++spins > (1u << 22)) break; }
    }
    unsigned njobs = 0;
    for (int job = blockIdx.x * 8 + wave; job < SG * 4 * (SEQ / CH); job += G * 8) {
        const int g = job & 31, pair = (job >> 5) & 3, chunk = job >> 7;
        ++njobs;
        if (PASS == 1 && chunk == SEQ / CH - 1) continue;
        bf16x8 bre[2], bim[2]; float ar[2], ai[2], xr[2], xi[2];
#pragma unroll
        for (int pt = 0; pt < 2; ++pt) {
            const int gp = g * SP + 32 * pt + n;
            const float* br = sp + SPF_BBR + (size_t)gp * SC + 8 * hh; const float* bi = sp + SPF_BBI + (size_t)gp * SC + 8 * hh;
            bre[pt] = pack_bf8(*(const f32x4*)br, *(const f32x4*)(br + 4)); bim[pt] = pack_bf8(*(const f32x4*)bi, *(const f32x4*)(bi + 4));
            ar[pt] = sp[SPF_A + gp * 2]; ai[pt] = sp[SPF_A + gp * 2 + 1];
            xr[pt] = 0.f; xi[pt] = 0.f;
        }
        const int bme = pair + 4 * hh;
        if (PASS == 2) {
#pragma unroll
            for (int pt = 0; pt < 2; ++pt) {
                const int gp = g * SP + 32 * pt + n;
                const float cr = sp[SPF_ACH + gp * 2], ci = sp[SPF_ACH + gp * 2 + 1];
                const float* e = CHS + ((size_t)((bme * SG + g) * (SEQ / CH)) * SP + 32 * pt + n) * 2;
                float sr = 0.f, si = 0.f;
                for (int i = 0; i < chunk; ++i) { const f32x2 ev = __builtin_bit_cast(f32x2, __hip_atomic_load((const unsigned long long*)(e + (size_t)i * SP * 2), __ATOMIC_RELAXED, __HIP_MEMORY_SCOPE_AGENT)); const float nr = cr * sr - ci * si + ev.x, ni = cr * si + ci * sr + ev.y; sr = nr; si = ni; }
                xr[pt] = sr; xi[pt] = si;
            }
        }
        bf16x8 cm[4]; f32x4 dsk;
        if (PASS == 2) {
            const int c = lane & 15, pq = 4 * (lane >> 4);
#pragma unroll
            for (int kk = 0; kk < 4; ++kk) {
                const f32x4 cr = *(const f32x4*)(p.in[7] + (size_t)(g * SC + c) * SP + pq + 16 * kk), ci = *(const f32x4*)(p.in[8] + (size_t)(g * SC + c) * SP + pq + 16 * kk);
                cm[kk] = pack_bf8((f32x4){cr.x, -ci.x, cr.y, -ci.y}, (f32x4){cr.z, -ci.z, cr.w, -ci.w});
            }
            dsk = *(const f32x4*)(p.in[9] + g * SC + 4 * (lane >> 4));
        }
        const bf16_t* up = US + (size_t)((((pair + 4 * seqA) * 16 + chunk) * 2 + (g >> 4))) * 65536 + pg8::tp_off(0, (g >> 1) & 3, 0, 0, (g >> 3) & 1, qA + 16 * ((g & 1) * 2 + hh));
#define US_STEP(st_) ((size_t)((((st_) >> 3) & 1) * 4096 + (((st_) >> 2) & 1) * 32768 + ((st_) & 3) * 1024))
        bf16x8 ufn = *(const bf16x8*)up;
#pragma unroll 1
        for (int st = 0; st < CH / 16; ++st) {
            const bf16x8 uf = ufn;
            ufn = *(const bf16x8*)(up + US_STEP(st + 1 < CH / 16 ? st + 1 : st));
            u32x2 uu[2];
            if (PASS == 2) {
#pragma unroll
                for (int sq = 0; sq < 2; ++sq) uu[sq] = *(const u32x2*)(US + (size_t)((((pair + 4 * sq) * 16 + chunk) * 2 + (g >> 4))) * 65536
                    + pg8::tp_off(0, (g >> 1) & 3, 0, 0, (g >> 3) & 1, (lane & 15) + 16 * ((g & 1) * 2 + (lane >> 5))) + US_STEP(st) + ((lane >> 4) & 1) * 4);
            }
#pragma unroll
            for (int pt = 0; pt < 2; ++pt) {
                f32x16 z;
#pragma unroll
                for (int i = 0; i < 16; ++i) z[i] = 0.f;
                const f32x16 accR = MFMA32(uf, bre[pt], z), accI = MFMA32(uf, bim[pt], z);
#pragma unroll
                for (int i = 0; i < 16; ++i) {
                    const float nr = fmaf(ar[pt], xr[pt], fmaf(-ai[pt], xi[pt], accR[i])), ni = fmaf(ar[pt], xi[pt], fmaf(ai[pt], xr[pt], accI[i]));
                    xr[pt] = nr; xi[pt] = ni;
                    if (PASS == 2) *(LAS unsigned*)(xs + (hh * 16 + i) * XS_PITCH + (32 * pt + n) * 4) = cvt_pk_bf16(nr, ni);
                }
            }
            if (PASS == 2) {
#pragma unroll
                for (int sq = 0; sq < 2; ++sq) {
                    f32x4 y = (f32x4){0.f, 0.f, 0.f, 0.f};
#pragma unroll
                    for (int kk = 0; kk < 4; ++kk) {
                        const bf16x8 xb = *(const LAS bf16x8*)(xs + (sq * 16 + (lane & 15)) * XS_PITCH + (8 * (lane >> 4) + 32 * kk) * 2);
                        y = MFMA16(cm[kk], xb, y);
                    }
                    const size_t off = ((size_t)(pair + 4 * sq) * SEQ + chunk * CH + st * 16 + (lane & 15)) * SW + g * SC + 4 * (lane >> 4);
                    const float o0 = gelu_tanh(y[0] + dsk[0] * bf_lo(uu[sq].x)), o1 = gelu_tanh(y[1] + dsk[1] * bf_hi(uu[sq].x)), o2 = gelu_tanh(y[2] + dsk[2] * bf_lo(uu[sq].y)), o3 = gelu_tanh(y[3] + dsk[3] * bf_hi(uu[sq].y));
                    u32x2 w; w.x = cvt_pk_bf16(o0, o1); w.y = cvt_pk_bf16(o2, o3);
                    *(u32x2*)(YG + off) = w;
                }
            }
        }
        if (PASS == 1) {
#pragma unroll
            for (int pt = 0; pt < 2; ++pt) {
                float* e = CHS + ((size_t)((bme * SG + g) * (SEQ / CH) + chunk) * SP + 32 * pt + n) * 2;
                __hip_atomic_store((unsigned long long*)e, __builtin_bit_cast(unsigned long long, (f32x2){xr[pt], xi[pt]}), __ATOMIC_RELAXED, __HIP_MEMORY_SCOPE_AGENT);
            }
        }
    }
    if (PASS == 1) {
        asm volatile("s_waitcnt vmcnt(0)" ::: "memory");
        if (lane == 0 && njobs) (void)__hip_atomic_fetch_add(ssmc, njobs, __ATOMIC_RELAXED, __HIP_MEMORY_SCOPE_AGENT);
    }
}

__device__ __forceinline__ void ln_phase(const Params& p, int G) {
    const int tid = opaque_tid(), lane = tid & 63, wave = tid >> 6;
    const int gw = blockIdx.x * 8 + wave, NGW = G * 8;
    const float* lg = p.in[15]; const float* lb = p.in[16];
    f32x4 gg[4], bb[4];
#pragma unroll
    for (int j = 0; j < 4; ++j) { gg[j] = *(const f32x4*)(lg + (lane + 64 * j) * 4); bb[j] = *(const f32x4*)(lb + (lane + 64 * j) * 4); }
    for (int m = gw; m < MT; m += NGW) {
        f32x4* row = (f32x4*)(p.out + (size_t)m * DM) + lane;
        f32x4 v[4]; float s = 0.f;
#pragma unroll
        for (int j = 0; j < 4; ++j) { v[j] = row[64 * j]; s += (v[j].x + v[j].y) + (v[j].z + v[j].w); }
        const float mean = wave_sum(s) * (1.f / DM); float s2 = 0.f;
#pragma unroll
        for (int j = 0; j < 4; ++j) { v[j] = v[j] - mean; s2 += (v[j].x * v[j].x + v[j].y * v[j].y) + (v[j].z * v[j].z + v[j].w * v[j].w); }
        const float rstd = 1.f / sqrtf(wave_sum(s2) * (1.f / DM) + LN_EPS);
#pragma unroll
        for (int j = 0; j < 4; ++j) row[64 * j] = v[j] * rstd * gg[j] + bb[j];
    }
}

#define RLX_AGENT __ATOMIC_RELAXED, __HIP_MEMORY_SCOPE_AGENT
#define XB_TMO      128
#define XB_XCNT(j)  (256  + 64 * (j))
#define XB_XSUB(j)  (1280 + 64 * (j))
#define XB_XGEN(j)  (2304 + 64 * (j))
#define XB_TOP      3328
#define XB_TOPGEN   3392
#define XCD_BAR_WORDS 3456
#define XB_SPIN_CAP (1u << 18)

__device__ __forceinline__ unsigned xb_ld(unsigned* p)              { return __hip_atomic_load(p, __ATOMIC_RELAXED, __HIP_MEMORY_SCOPE_AGENT); }
__device__ __forceinline__ unsigned xb_add(unsigned* p, unsigned v) { return __hip_atomic_fetch_add(p, v, __ATOMIC_RELAXED, __HIP_MEMORY_SCOPE_AGENT); }
__device__ __forceinline__ unsigned xb_xcc_id() { return (unsigned)__builtin_amdgcn_s_getreg((3 << 11) | 20) & 0xFu; }
#define XB_SPIN(cond, bar) do { unsigned _sp = 0; while (cond) { __builtin_amdgcn_s_sleep(1); \
    if ((++_sp & 255u) == 0u) { if (xb_ld(&(bar)[XB_TMO])) break; if (_sp > XB_SPIN_CAP) { atomicAdd(&(bar)[XB_TMO], 1u); break; } } } } while (0)

struct XcdBarrier {
    unsigned* bar; unsigned x;
    volatile LAS unsigned* st;
};

__device__ __forceinline__ XcdBarrier xcd_barrier_post(unsigned* bar, volatile LAS unsigned* st) {
    XcdBarrier b; b.bar = bar; b.x = xb_xcc_id(); b.st = st;
    if (threadIdx.x == 0) (void)xb_add(&bar[XB_XCNT(b.x)], 1u);
    return b;
}
__device__ __forceinline__ void xcd_barrier_complete(unsigned* bar, unsigned x, unsigned& nloc, unsigned& nx) {
    const unsigned G = gridDim.x * gridDim.y * gridDim.z;
    unsigned sum, cnt, mine, sp = 0u;
    for (;;) {
        sum = 0u; cnt = 0u; mine = 0u;
#pragma unroll
        for (unsigned j = 0; j < 16; ++j) { const unsigned c = xb_ld(&bar[XB_XCNT(j)]); sum += c; cnt += (c > 0u) ? 1u : 0u; mine = (j == x) ? c : mine; }
        if (sum == G) break;
        __builtin_amdgcn_s_sleep(1);
        if ((++sp & 255u) == 0u) { if (xb_ld(&bar[XB_TMO])) break; if (sp > XB_SPIN_CAP) { atomicAdd(&bar[XB_TMO], 1u); break; } }
    }
    nloc = mine > 0u ? mine : 1u; nx = cnt > 0u ? cnt : 1u;
}

__device__ __forceinline__ void xcd_barrier(const XcdBarrier& b) {
    asm volatile("s_waitcnt vmcnt(0)" ::: "memory");
    __syncthreads();
    if (threadIdx.x == 0) {
        unsigned* bar = b.bar;
        __builtin_amdgcn_s_waitcnt(0);
        unsigned nloc = b.st[0], nx = b.st[1];
        if (nloc == 0u) { xcd_barrier_complete(bar, b.x, nloc, nx); b.st[0] = nloc; b.st[1] = nx; }
        const unsigned old = xb_add(&bar[XB_XSUB(b.x)], 1u);
        const unsigned gen = old / nloc;
        if (old + 1u == (gen + 1u) * nloc) {
            __builtin_amdgcn_fence(__ATOMIC_RELEASE, "agent");
            asm volatile("s_waitcnt vmcnt(0)" ::: "memory");
            const unsigned og = xb_add(&bar[XB_TOP], 1u);
            const unsigned tg = og / nx;
            if (og + 1u == (tg + 1u) * nx) xb_add(&bar[XB_TOPGEN], 1u);
            else XB_SPIN(xb_ld(&bar[XB_TOPGEN]) == tg, bar);
            __builtin_amdgcn_fence(__ATOMIC_ACQUIRE, "agent");
            xb_add(&bar[XB_XGEN(b.x)], 1u);
            asm volatile("s_waitcnt vmcnt(0)" ::: "memory");
        } else {
            XB_SPIN(xb_ld(&bar[XB_XGEN(b.x)]) == gen, bar);
            __builtin_amdgcn_fence(__ATOMIC_ACQUIRE, "agent");
            asm volatile("s_waitcnt vmcnt(0)" ::: "memory");
        }
    }
    __syncthreads();
}


#ifndef REP_P0
#define REP_P0 1
#endif
#ifndef REP_P1
#define REP_P1 1
#endif
#ifndef REP_ATT
#define REP_ATT 1
#endif
#ifndef REP_SSM
#define REP_SSM 1
#endif
#ifndef REP_P4
#define REP_P4 1
#endif
#ifndef REP_P5
#define REP_P5 1
#endif
#ifndef REP_P6
#define REP_P6 1
#endif
#ifndef REP_SYNC
#define REP_SYNC 1
#endif
__global__ void __launch_bounds__(512, 2) mega_fwd(Params p) {
    extern __shared__ __attribute__((aligned(16))) unsigned char lds_raw[];
    LAS unsigned char* lds = (LAS unsigned char*)lds_raw;
    cg::grid_group grid = cg::this_grid();
    const int G = gridDim.x;
    unsigned char* ws = p.ws;
    bf16_t* XB = (bf16_t*)(ws + WS_XB); bf16_t* WIN = (bf16_t*)(ws + WS_WIN);
    bf16_t* GL = (bf16_t*)p.out;
    volatile LAS unsigned* bst = (volatile LAS unsigned*)(lds + LDS_BYTES - 16);
    if (threadIdx.x < 4) bst[threadIdx.x] = 0u;
    __syncthreads();
    const XcdBarrier xbar = xcd_barrier_post((unsigned*)(ws + WS_BAR), bst);
#define GRID_BAR() xcd_barrier(xbar)

#pragma unroll 1
    for (int rep = 0; rep < REP_P0; ++rep) { phase0(p, lds, G); __syncthreads(); }
    if (p.ws == nullptr) grid.sync();
#pragma unroll 1
    for (int rep = 0; rep < REP_SYNC; ++rep) GRID_BAR();

    {
        pg8::P1Order S{G, (int)blockIdx.x, REP_P1};
        pg8::gemm_phase_p1(lds, XB, WIN, ws, GL, S);
    }
    GRID_BAR();

    ssm_pass1_fast(p, G);
    __syncthreads();
#pragma unroll 1
    for (int rep = 0; rep < REP_ATT; ++rep) attn_phase(p, lds, G);
#pragma unroll 1
    for (int rep = 0; rep < REP_SSM; ++rep) ssm_pass<2>(p, lds, G);
    GRID_BAR();

    {
        pg8::Gemm g{(const bf16_t*)(ws + WS_YG), (const bf16_t*)(ws + WS_WGLU), SW, 1, 1}; pg8::Order S; S.init(MT / 256, SW / 256, G, (int)blockIdx.x, 0, 1, REP_P4);
        pg8::EpiGlu E{(const bf16_t*)(ws + WS_YG), (const bf16_t*)(ws + WS_ZS), p.in[11], (bf16_t*)(ws + WS_AT2)};
        pg8::gemm_phase<pg8::EpiGlu>(lds, g, S, E);
    }
    GRID_BAR();

    {
        pg8::Gemm g{(const bf16_t*)(ws + WS_AT2), (const bf16_t*)(ws + WS_WUP), 2 * AW, 1, 1}; pg8::Order S; S.init(MT / 256, DM / 256, G, (int)blockIdx.x, 0, 1, REP_P5);
        pg8::EpiMerge E{GL, (bf16_t*)(ws + WS_MG)};
        pg8::gemm_phase<pg8::EpiMerge>(lds, g, S, E);
    }
    GRID_BAR();

#pragma unroll 1
    for (int hc = 0; hc < 2; ++hc) {
        pg8::Gemm g{(const bf16_t*)(ws + WS_MG) + (size_t)hc * (MT / 2) * DM, (const bf16_t*)(ws + WS_WO), DM, 1, 1}; pg8::Order S; S.init(MT / 512, DM / 256, G, (int)blockIdx.x, 0, 1, 1);
        pg8::EpiLnOut E{p.in[0], p.out, p.in[15], p.in[16], (float*)(ws + WS_STATS), (unsigned*)(ws + WS_CNT), hc * (MT / 2), hc * (MT / 512)};
        pg8::gemm_phase<pg8::EpiLnOut>(lds, g, S, E);
    }
}

extern "C" void kernel_launch(void* const* d_in, const int* in_sizes, int n_in, void* d_out, int out_size, void* d_ws, size_t ws_size, hipStream_t stream) {
    static int grid = 0;
    if (grid == 0) {
        if (n_in != 17 || out_size != MT * DM || ws_size < WS_END) { fprintf(stderr, "kernel_launch: unexpected shapes (n_in %d out %d ws %zu)\n", n_in, out_size, ws_size); grid = -1; return; }
        int dev = 0, cus = 0, per_cu = 0;
        hipGetDevice(&dev);
        hipDeviceGetAttribute(&cus, hipDeviceAttributeMultiprocessorCount, dev);
        hipFuncSetAttribute((const void*)mega_fwd, hipFuncAttributeMaxDynamicSharedMemorySize, LDS_BYTES);
        hipOccupancyMaxActiveBlocksPerMultiprocessor(&per_cu, (const void*)mega_fwd, 512, LDS_BYTES);
        if (per_cu < 1) { fprintf(stderr, "kernel_launch: occupancy query says %d blocks per CU\n", per_cu); per_cu = 1; }
        grid = cus;
        (void)hipGetLastError();
    }
    if (grid < 0) return;
    Params p{};
    for (int i = 0; i < 17; ++i) p.in[i] = (const float*)d_in[i];
    p.out = (float*)d_out; p.ws = (unsigned char*)d_ws;
    if (hipMemsetAsync((char*)d_ws + WS_BAR, 0, BAR_BYTES, stream) != hipSuccess) { fprintf(stderr, "kernel_launch: memset failed\n"); return; }
    void* args[] = {&p};
    hipError_t e = hipLaunchCooperativeKernel((const void*)mega_fwd, dim3(grid), dim3(512), args, LDS_BYTES, stream);
    if (e != hipSuccess) fprintf(stderr, "cooperative launch failed: %s (grid %d)\n", hipGetErrorString(e), grid);
}
```

```cpp
#include <hip/hip_runtime.h>
#include <hip/hip_cooperative_groups.h>
#include <cstdio>
#include <cstdint>
namespace cg = cooperative_groups;

#define LAS __attribute__((address_space(3)))
typedef unsigned short bf16_t;
typedef short bf16x8 __attribute__((ext_vector_type(8)));
typedef float f32x4 __attribute__((ext_vector_type(4)));
typedef float f32x2 __attribute__((ext_vector_type(2)));
typedef unsigned u32x4 __attribute__((ext_vector_type(4)));
typedef unsigned u32x2 __attribute__((ext_vector_type(2)));

constexpr int NB = 8, SEQ = 4096, MT = NB * SEQ, DM = 1024, DIN = 8192, QKVW = 1536, AW = 512, SW = 512;
constexpr int SG = 32, SC = 16, SP = 64;
constexpr float LN_EPS = 1e-5f;
constexpr float DN_ALPHA = 1.189207115002721f;

constexpr size_t MiB = 1u << 20;
constexpr size_t WS_XB = 0;
constexpr size_t WS_AT2 = 0;
constexpr size_t WS_YG = 480 * MiB;
constexpr size_t WS_WIN = 64 * MiB;
constexpr size_t WS_WGLU = 80 * MiB, WS_WUP = 81 * MiB, WS_WO = 83 * MiB;
constexpr size_t WS_SSMP = 85 * MiB;
constexpr size_t WS_CHST = 86 * MiB;
constexpr size_t WS_BAR = 90 * MiB;
constexpr size_t WS_STATS = WS_BAR + 16384, WS_CNT = WS_STATS + (size_t)MT * 2 * 4, WS_SSMC = WS_CNT + 128 * 256, BAR_BYTES = 16384 + (size_t)MT * 2 * 4 + 128 * 256 + 256;
constexpr size_t WS_Q = 96 * MiB, WS_K = 192 * MiB, WS_VT = 288 * MiB;
constexpr size_t WS_ZA = 384 * MiB, WS_US = 416 * MiB, WS_ZS = 448 * MiB;
constexpr size_t WS_MG = 288 * MiB;
constexpr size_t WS_END = 512 * MiB;

constexpr int SPF_A = 0;
constexpr int SPF_ACH = SPF_A + SG * SP * 2;
constexpr int SPF_BBR = SPF_ACH + SG * SP * 2;
constexpr int SPF_BBI = SPF_BBR + SG * SP * SC;
constexpr int SPF_END = SPF_BBI + SG * SP * SC;

constexpr int LDS_BYTES = 147456;

__device__ __forceinline__ int opaque_tid() { int t = threadIdx.x; asm volatile("" : "+v"(t)); return t; }
typedef __bf16 bf16x2_t __attribute__((ext_vector_type(2)));
typedef float f32x16 __attribute__((ext_vector_type(16)));
#define MFMA32(a, b, c) __builtin_amdgcn_mfma_f32_32x32x16_bf16((a), (b), (c), 0, 0, 0)
__device__ __forceinline__ unsigned cvt_pk_bf16(float lo, float hi) { f32x2 v = {lo, hi}; bf16x2_t r = __builtin_convertvector(v, bf16x2_t); return __builtin_bit_cast(unsigned, r); }
__device__ __forceinline__ float bf_lo(unsigned w) { return __builtin_bit_cast(float, w << 16); }
__device__ __forceinline__ float bf_hi(unsigned w) { return __builtin_bit_cast(float, w & 0xffff0000u); }
__device__ __forceinline__ float bf2f(bf16_t b) { return __builtin_bit_cast(float, ((unsigned)b) << 16); }
__device__ __forceinline__ float sigmoidf_(float v) { return __builtin_amdgcn_rcpf(1.f + __expf(-v)); }
__device__ __forceinline__ float siluf_(float v) { return v * sigmoidf_(v); }
__device__ __forceinline__ float gelu_tanh(float v) { const float z = 1.5957691216057308f * (v + 0.044715f * v * v * v); return v * sigmoidf_(z); }
__device__ __forceinline__ float wave_sum(float v) {
#pragma unroll
    for (int o = 1; o < 64; o <<= 1) v += __shfl_xor(v, o);
    return v;
}
__device__ __forceinline__ float wave_max(float v) {
#pragma unroll
    for (int o = 1; o < 64; o <<= 1) v = fmaxf(v, __shfl_xor(v, o));
    return v;
}

namespace pg8 {
constexpr int BM = 256, BK = 64, HALF = 128, HTB = HALF * BK * 2, STAGE_BYTES = 8 * HTB, NXCD = 8, WGM = 8;
__host__ __device__ __forceinline__ int lds_byte(int r, int c) { const int st = (r >> 4) * 2 + (c >> 5), rr = r & 15, cc = c & 31, ob = rr * 64 + cc * 2; return st * 1024 + (ob ^ (((ob >> 9) & 1) << 5)); }
__host__ __device__ __forceinline__ void stage_rc(int b, int& R, int& C) { const int st = b / 1024, sb = b % 1024, swz = sb ^ (((sb >> 9) & 1) << 5); R = (st >> 1) * 16 + swz / 64; C = (st & 1) * 32 + (swz % 64) / 2; }
__host__ __device__ __forceinline__ int perm32(int rho) { const int n = rho >> 4, i = rho & 15; return 8 * (i >> 2) + 4 * n + (i & 3); }

struct Unit { int pm, pn; };
struct Gemm { const bf16_t* A; const bf16_t* Bt; int K; int rsA; int rsB; };

struct Order {
    int nM, nN, nwg, G, c, mode, r, rep, gi;
    __device__ __forceinline__ void init(int nM_, int nN_, int G_, int c_, int mode_, int r_, int rep_ = 1, int gi_ = 0) { nM = nM_; nN = nN_; nwg = nM * nN; G = G_; c = c_; mode = mode_; r = r_; rep = rep_; gi = gi_; }
    __device__ __forceinline__ bool next(int i, Unit& u) const {
        const long L = (long)i * G + c; if (L >= (long)nwg * rep) return false;
        int wgid = (int)(L % nwg); { const int q = nwg / NXCD, rr = nwg % NXCD, xcd = wgid % NXCD, off = wgid / NXCD; wgid = (xcd < rr ? xcd * (q + 1) : rr * (q + 1) + (xcd - rr) * q) + off; }
        const int nig = WGM * nN, gid = wgid / nig, fm = gid * WGM, gsz = (nM - fm) < WGM ? (nM - fm) : WGM;
        u.pm = fm + ((wgid % nig) % gsz); u.pn = (wgid % nig) / gsz; return true;
    }
    __device__ __forceinline__ size_t tok0(int t) const { const int b = t >> 4, q = t & 15, pos0 = q * 256, NS = SEQ / r, ph = pos0 / NS, n0 = pos0 % NS; return (size_t)(b * SEQ + n0 * r + ph); }
    __device__ __forceinline__ size_t a_off(const Unit& u, int K) const {
        if (mode == 3) return tok0(u.pm) * K * 2;
        return (size_t)u.pm * 256 * K * 2;
    }
    __device__ __forceinline__ size_t b_off(const Unit& u, int K) const {
        if (mode == 0) return (size_t)u.pn * 256 * K * 2;
        if (mode == 1) { const int wrow = u.pn < 2 ? 256 * u.pn : u.pn < 4 ? QKVW + 256 * (u.pn - 2) : 3 * QKVW + 256 * (u.pn - 4); return (size_t)wrow * K * 2; }
        if (mode == 3) { const int wrow = u.pn < 2 ? gi * 512 + 256 * u.pn : QKVW + gi * 512 + 256 * (u.pn - 2); return (size_t)wrow * K * 2; }
        return tok0(u.pn) * K * 2;
    }
};

template <class Epi, bool ALIGN_EPI = true>
__device__ __forceinline__ void gemm_phase(LAS unsigned char* lds, const Gemm g, const Order& S, const Epi& E) {
    const int tid = opaque_tid(), wid = __builtin_amdgcn_readfirstlane(tid >> 6), lane = tid & 63, wr = wid >> 2, wc = wid & 3, fr = lane & 15, fq = lane >> 4;
    const int K = g.K, nt = K / BK;
    unsigned voffA[2], voffB[2];
#pragma unroll
    for (int i = 0; i < 2; ++i) { int R, C; stage_rc(tid * 16 + i * 8192, R, C); const int Rb = Epi::PERM ? ((R & ~31) + perm32(R & 31)) : R;
        voffA[i] = (unsigned)(R * g.rsA * K + C) * 2u; voffB[i] = (unsigned)(Rb * g.rsB * K + C) * 2u; }
    const size_t kstep = (size_t)(BK * 2);
    const size_t hstep = (size_t)HALF * K * 2 * (size_t)g.rsA;
    const size_t hstepB = (size_t)HALF * K * 2 * (size_t)g.rsB;
    const unsigned ldsw = (unsigned)wid * 1024u;
    const int aoff = lds_byte(wr * 64 + fr, fq * 8), boff = lds_byte(wc * 32 + fr, fq * 8);
#define PG8_SA(b, h) (((b) * 2 + (h)) * HTB)
#define PG8_SB(b, h) ((4 + (b) * 2 + (h)) * HTB)
#define PG8_STAGE(bufoff, gbase, voff) do { _Pragma("unroll") for (int _i = 0; _i < 2; ++_i) \
        __builtin_amdgcn_global_load_lds((const unsigned*)((const char*)(gbase) + (voff)[_i]), (LAS unsigned*)(lds + (bufoff) + ldsw + _i * 8192), 16, 0, 0); } while (0)
#define PG8_LDA(dst, b, h) do { _Pragma("unroll") for (int m = 0; m < 4; ++m) _Pragma("unroll") for (int k = 0; k < 2; ++k) dst[m][k] = *(const LAS bf16x8*)(lds + PG8_SA(b, h) + aoff + m * 2048 + k * 1024); } while (0)
#define PG8_LDB(dst, b, h) do { _Pragma("unroll") for (int n = 0; n < 2; ++n) _Pragma("unroll") for (int k = 0; k < 2; ++k) dst[n][k] = *(const LAS bf16x8*)(lds + PG8_SB(b, h) + boff + n * 2048 + k * 1024); } while (0)
#define PG8_MMA(ai, bj, At, Bt) do { __builtin_amdgcn_s_setprio(1); _Pragma("unroll") for (int m = 0; m < 4; ++m) _Pragma("unroll") for (int n = 0; n < 2; ++n) _Pragma("unroll") for (int k = 0; k < 2; ++k) \
        acc[ai][bj][m][n] = __builtin_amdgcn_mfma_f32_16x16x32_bf16(Bt[n][k], At[m][k], acc[ai][bj][m][n], 0, 0, 0); __builtin_amdgcn_s_setprio(0); } while (0)
#define PG8_WAIT_V(n) asm volatile("s_waitcnt vmcnt(" #n ")" ::: "memory")
#define PG8_WAIT_L(n) asm volatile("s_waitcnt lgkmcnt(" #n ")" ::: "memory")
#define PG8_BAR __builtin_amdgcn_s_barrier()
#define PG8_SCHED __builtin_amdgcn_sched_barrier(0)
    Unit cur, nxt; int ui = 0;
    if (!S.next(0, cur)) return;
    f32x4 acc[2][2][4][2];
#pragma unroll
    for (int a = 0; a < 2; ++a)
#pragma unroll
        for (int b = 0; b < 2; ++b)
#pragma unroll
            for (int m = 0; m < 4; ++m)
#pragma unroll
                for (int n = 0; n < 2; ++n) acc[a][b][m][n] = (f32x4){0.f, 0.f, 0.f, 0.f};
    bf16x8 At[4][2], B0[2][2], B1[2][2];
    const char* cA = (const char*)g.A + S.a_off(cur, K); const char* cB = (const char*)g.Bt + S.b_off(cur, K);
    PG8_STAGE(PG8_SB(0, 0), cB, voffB); PG8_STAGE(PG8_SB(0, 1), cB + hstepB, voffB); PG8_STAGE(PG8_SA(0, 0), cA, voffA); PG8_STAGE(PG8_SA(0, 1), cA + hstep, voffA);
    if (wr == 1) PG8_BAR;
    PG8_WAIT_V(2); PG8_BAR;
    PG8_STAGE(PG8_SB(1, 0), cB + kstep, voffB); PG8_STAGE(PG8_SA(1, 0), cA + kstep, voffA); PG8_STAGE(PG8_SB(1, 1), cB + hstepB + kstep, voffB);
    PG8_WAIT_V(6); PG8_BAR;
    for (;;) {
        const bool has_next = S.next(ui + 1, nxt);
        const char* nA = has_next ? (const char*)g.A + S.a_off(nxt, K) : cA; const char* nB = has_next ? (const char*)g.Bt + S.b_off(nxt, K) : cB;
        for (int t = 0; t < nt; t += 2) {
            const bool last = (t == nt - 2);
            const char* a1 = cA + (size_t)(t + 1) * kstep;
            const char* a2 = last ? nA : cA + (size_t)(t + 2) * kstep; const char* b2 = last ? nB : cB + (size_t)(t + 2) * kstep;
            const char* a3 = a2 + kstep; const char* b3 = b2 + kstep;
            if constexpr (Epi::MID) { if (t == nt / 2) E.mid(acc, cur, wr, wc, fr, fq); }
            PG8_LDB(B0, 0, 0); PG8_LDB(B1, 0, 1); PG8_SCHED; PG8_LDA(At, 0, 0); PG8_STAGE(PG8_SA(1, 1), a1 + hstep, voffA);
            PG8_WAIT_V(8); PG8_WAIT_L(0); PG8_BAR; PG8_MMA(0, 0, At, B0); PG8_MMA(0, 1, At, B1); PG8_BAR; PG8_SCHED;
            PG8_LDA(At, 0, 1); PG8_STAGE(PG8_SB(0, 0), b2, voffB); PG8_STAGE(PG8_SB(0, 1), b2 + hstepB, voffB); PG8_STAGE(PG8_SA(0, 0), a2, voffA);
            PG8_WAIT_V(8); PG8_WAIT_L(0); PG8_BAR; PG8_MMA(1, 0, At, B0); PG8_MMA(1, 1, At, B1); PG8_BAR; PG8_SCHED;
            PG8_LDB(B0, 1, 0); PG8_LDB(B1, 1, 1); PG8_SCHED; PG8_LDA(At, 1, 0); PG8_STAGE(PG8_SA(0, 1), a2 + hstep, voffA);
            PG8_WAIT_V(8); PG8_WAIT_L(0); PG8_BAR; PG8_MMA(0, 0, At, B0); PG8_MMA(0, 1, At, B1); PG8_BAR; PG8_SCHED;
            PG8_LDA(At, 1, 1); PG8_STAGE(PG8_SB(1, 0), b3, voffB); PG8_STAGE(PG8_SB(1, 1), b3 + hstepB, voffB); PG8_STAGE(PG8_SA(1, 0), a3, voffA);
            PG8_WAIT_V(8); PG8_WAIT_L(0); PG8_BAR; PG8_MMA(1, 0, At, B0); PG8_MMA(1, 1, At, B1); PG8_BAR; PG8_SCHED;
        }
        if constexpr (ALIGN_EPI) { if (wr == 0) PG8_BAR; }
        if constexpr (!Epi::AFTER) E(acc, cur, wr, wc, fr, fq);
        if (!has_next) break;
#pragma unroll
        for (int a = 0; a < 2; ++a)
#pragma unroll
            for (int b = 0; b < 2; ++b)
#pragma unroll
                for (int m = 0; m < 4; ++m)
#pragma unroll
                    for (int n = 0; n < 2; ++n) acc[a][b][m][n] = (f32x4){0.f, 0.f, 0.f, 0.f};
        cur = nxt; cA = nA; cB = nB; ++ui;
        if constexpr (ALIGN_EPI) { if (wr == 1) PG8_BAR; }
    }
    PG8_WAIT_V(0);
    if constexpr (!ALIGN_EPI) { if (wr == 0) PG8_BAR; }
    PG8_BAR;
    if constexpr (Epi::AFTER) E.after(acc, cur, wr, wc, fr, fq, lds);
#undef PG8_SA
#undef PG8_SB
#undef PG8_STAGE
#undef PG8_LDA
#undef PG8_LDB
#undef PG8_MMA
#undef PG8_WAIT_V
#undef PG8_WAIT_L
#undef PG8_BAR
#undef PG8_SCHED
}

__device__ __forceinline__ u32x4 pack8(f32x4 v0, f32x4 v1) { u32x4 w; w.x = cvt_pk_bf16(v0[0], v0[1]); w.y = cvt_pk_bf16(v0[2], v0[3]); w.z = cvt_pk_bf16(v1[0], v1[1]); w.w = cvt_pk_bf16(v1[2], v1[3]); return w; }
__device__ __forceinline__ void unpack8(u32x4 w, f32x4& a, f32x4& b) { a = (f32x4){bf_lo(w.x), bf_hi(w.x), bf_lo(w.y), bf_hi(w.y)}; b = (f32x4){bf_lo(w.z), bf_hi(w.z), bf_lo(w.w), bf_hi(w.w)}; }

__device__ __forceinline__ void store_tile_bf16(const f32x4 (&acc)[2][2][4][2], bf16_t* base, int ld, int row0, int col0) {
#pragma unroll
    for (int ai = 0; ai < 2; ++ai)
#pragma unroll
        for (int m = 0; m < 4; ++m) { bf16_t* rowp = base + (size_t)(row0 + ai * HALF + m * 16) * ld + col0;
#pragma unroll
            for (int bj = 0; bj < 2; ++bj) __builtin_nontemporal_store(pack8(acc[ai][bj][m][0], acc[ai][bj][m][1]), (u32x4*)(rowp + bj * HALF)); }
}
__device__ __forceinline__ size_t qk_addr(int b, int g, int h, int c, int pos) { return (((((size_t)(b * 3 + g) * 8 + h) * (SEQ / 32) + (pos >> 5)) * 8 + c) * 32 + (pos & 31)) * 8; }
__device__ __forceinline__ void store_tile_qk(const f32x4 (&acc)[2][2][4][2], bf16_t* base, int b, int g, int hb, int pos0, int wr, int wc, int fr, int fq) {
#pragma unroll
    for (int bj = 0; bj < 2; ++bj) { const int j = bj * HALF + wc * 32 + 8 * fq; bf16_t* cp = base + qk_addr(b, g, hb + (j >> 6), (j & 63) >> 3, pos0 + wr * 64 + fr);
#pragma unroll
        for (int ai = 0; ai < 2; ++ai)
#pragma unroll
            for (int m = 0; m < 4; ++m) __builtin_nontemporal_store(pack8(acc[ai][bj][m][0], acc[ai][bj][m][1]), (u32x4*)(cp + (size_t)((ai * 4 + (m >> 1)) * 8 * 32 + (m & 1) * 16) * 8)); }
}
__device__ __forceinline__ size_t tp_off(int wr, int wc, int ai, int m, int bj, int lane) { return (size_t)(((((wr * 4 + wc) * 2 + ai) * 4 + m) * 2 + bj) * 512 + lane * 8); }
__device__ __forceinline__ f32x4 silu4(f32x4 v) { return (f32x4){siluf_(v[0]), siluf_(v[1]), siluf_(v[2]), siluf_(v[3])}; }
template <bool SILU = false>
__device__ __forceinline__ void store_tile_priv(const f32x4 (&acc)[2][2][4][2], bf16_t* tile, int wr, int wc, int lane) {
#pragma unroll
    for (int ai = 0; ai < 2; ++ai)
#pragma unroll
        for (int m = 0; m < 4; ++m) {
#pragma unroll
            for (int bj = 0; bj < 2; ++bj) __builtin_nontemporal_store(SILU ? pack8(silu4(acc[ai][bj][m][0]), silu4(acc[ai][bj][m][1])) : pack8(acc[ai][bj][m][0], acc[ai][bj][m][1]), (u32x4*)(tile + tp_off(wr, wc, ai, m, bj, lane)));
            if (SILU) __builtin_amdgcn_sched_barrier(0);
        }
}
struct EpiProj {
    static constexpr bool PERM = true, MID = false, AFTER = false;
    unsigned char* ws; bf16_t* GL;
    __device__ __forceinline__ void operator()(const f32x4 (&acc)[2][2][4][2], const Unit& u, int wr, int wc, int fr, int fq) const {
        const int pn = u.pn;
        if (pn < 4) { store_tile_qk(acc, (bf16_t*)(ws + (pn < 2 ? WS_Q : WS_K)), u.pm >> 4, 0, 4 * (pn & 1), (u.pm & 15) * 256, wr, wc, fr, fq); return; }
        if (pn >= 10) {
            int lane = fr + 16 * fq; asm volatile("" : "+v"(lane));
            bf16_t* rb = GL + (size_t)(u.pm * 8 + (pn - 10)) * 32768 + (size_t)((wr * 4 + wc) * 8 * 512 + lane * 8);
#pragma unroll
            for (int ai = 0; ai < 2; ++ai) {
                bf16_t* rp = rb + ai * 4 * 512; bf16_t* gp = rp + (size_t)(MT / 256) * 8 * 32768;
#pragma unroll
                for (int m = 0; m < 4; ++m) { f32x4 r0, r1, g0, g1;
#pragma unroll
                    for (int j = 0; j < 4; ++j) {
                        const float es0 = __expf(-fmaxf(acc[ai][1][m][0][j], -80.f)), es1 = __expf(-fmaxf(acc[ai][1][m][1][j], -80.f));
                        g0[j] = __builtin_amdgcn_rcpf(1.f + es0); g1[j] = __builtin_amdgcn_rcpf(1.f + es1);
                        r0[j] = (1.f + es0) * __builtin_amdgcn_rcpf(1.f + __expf(-acc[ai][0][m][0][j])); r1[j] = (1.f + es1) * __builtin_amdgcn_rcpf(1.f + __expf(-acc[ai][0][m][1][j])); }
                    __builtin_nontemporal_store(pack8(g0, g1), (u32x4*)(gp + m * 512));
                    __builtin_nontemporal_store(pack8(r0, r1), (u32x4*)(rp + m * 512));
                    __builtin_amdgcn_sched_barrier(0); }
            }
            return; }
        if (pn >= 8) { store_tile_priv<true>(acc, (bf16_t*)(ws + WS_ZS) + (size_t)(u.pm * 2 + (pn - 8)) * 65536, wr, wc, fr + 16 * fq); return; }
        if (pn < 6) store_tile_priv<true>(acc, (bf16_t*)(ws + WS_ZA) + (size_t)(u.pm * 2 + (pn & 1)) * 65536, wr, wc, fr + 16 * fq);
        else store_tile_priv(acc, (bf16_t*)(ws + WS_US) + (size_t)(u.pm * 2 + (pn & 1)) * 65536, wr, wc, fr + 16 * fq);
    }
};
struct EpiQK {
    static constexpr bool PERM = true, MID = false, AFTER = false;
    bf16_t *Q, *Kb; int gi;
    __device__ __forceinline__ void operator()(const f32x4 (&acc)[2][2][4][2], const Unit& u, int wr, int wc, int fr, int fq) const {
        store_tile_qk(acc, u.pn < 2 ? Q : Kb, u.pm >> 4, gi, 4 * (u.pn & 1), (u.pm & 15) * 256, wr, wc, fr, fq);
    }
};
struct EpiVt2 {
    static constexpr bool PERM = true, MID = false, AFTER = false;
    bf16_t* V; int gi;
    __device__ __forceinline__ void operator()(const f32x4 (&acc)[2][2][4][2], const Unit& u, int wr, int wc, int fr, int fq) const {
        const int b = u.pn >> 4, pos0 = (u.pn & 15) * 256;
#pragma unroll
        for (int ai = 0; ai < 2; ++ai)
#pragma unroll
            for (int m = 0; m < 4; ++m) { const int ch = u.pm * BM + ai * HALF + wr * 64 + m * 16 + fr, h = ch >> 6, d = ch & 63;
#pragma unroll
                for (int bj = 0; bj < 2; ++bj) { const int pos = pos0 + bj * HALF + wc * 32 + 8 * fq;
                    __builtin_nontemporal_store(pack8(acc[ai][bj][m][0], acc[ai][bj][m][1]), (u32x4*)(V + ((((size_t)(gi * 8 + h) * 8 + b) * (SEQ / 8) + (pos >> 3)) * 64 + d) * 8)); } }
    }
};
struct EpiPlain {
    static constexpr bool PERM = true, MID = false, AFTER = false;
    bf16_t* O; int ld;
    __device__ __forceinline__ void operator()(const f32x4 (&acc)[2][2][4][2], const Unit& u, int wr, int wc, int fr, int fq) const {
        store_tile_bf16(acc, O, ld, u.pm * BM + wr * 64 + fr, u.pn * BM + wc * 32 + 8 * fq);
    }
};
struct EpiGlu {
    static constexpr bool PERM = true, MID = false, AFTER = false;
    const bf16_t* YG; const bf16_t* ZS; const float* bglu; bf16_t* Y2;
    __device__ __forceinline__ void operator()(const f32x4 (&acc)[2][2][4][2], const Unit& u, int wr, int wc, int fr, int fq) const {
        const int row0 = u.pm * BM + wr * 64 + fr, col0 = u.pn * BM + wc * 32 + 8 * fq;
        f32x4 bv[2][2];
#pragma unroll
        for (int bj = 0; bj < 2; ++bj) { bv[bj][0] = *(const f32x4*)(bglu + col0 + bj * HALF); bv[bj][1] = *(const f32x4*)(bglu + col0 + bj * HALF + 4); }
#pragma unroll
        for (int ai = 0; ai < 2; ++ai)
#pragma unroll
            for (int m = 0; m < 4; ++m) { const size_t off = (size_t)(row0 + ai * HALF + m * 16) * SW + col0;
#pragma unroll
                for (int bj = 0; bj < 2; ++bj) {
                    f32x4 y0, y1, z0, z1; unpack8(*(const u32x4*)(YG + off + bj * HALF), y0, y1); unpack8(__builtin_nontemporal_load((const u32x4*)(ZS + (size_t)(u.pm * 2 + u.pn) * 65536 + tp_off(wr, wc, ai, m, bj, fr + 16 * fq))), z0, z1);
                    f32x4 v0 = acc[ai][bj][m][0] + bv[bj][0], v1 = acc[ai][bj][m][1] + bv[bj][1], o0, o1;
#pragma unroll
                    for (int j = 0; j < 4; ++j) { o0[j] = y0[j] * sigmoidf_(v0[j]) * z0[j]; o1[j] = y1[j] * sigmoidf_(v1[j]) * z1[j]; }
                    *(u32x4*)(Y2 + (size_t)(row0 + ai * HALF + m * 16) * (2 * AW) + AW + col0 + bj * HALF) = pack8(o0, o1); } }
    }
};
struct EpiMerge {
    static constexpr bool PERM = true, MID = true, AFTER = false;
    const bf16_t* GL; bf16_t* MG;
    __device__ __forceinline__ void mid(f32x4 (&acc)[2][2][4][2], const Unit& u, int wr, int wc, int fr, int fq) const {
        asm volatile("" : "+v"(fr), "+v"(fq));
        const int lane = fr + 16 * fq;
#pragma unroll
        for (int ai = 0; ai < 2; ++ai)
#pragma unroll
            for (int m = 0; m < 4; ++m)
#pragma unroll
                for (int bj = 0; bj < 2; ++bj) {
                    f32x4 r0, r1; unpack8(__builtin_nontemporal_load((const u32x4*)(GL + (size_t)(u.pm * 8 + 2 * u.pn + bj) * 32768 + (size_t)((((wr * 4 + wc) * 2 + ai) * 4 + m) * 512 + lane * 8))), r0, r1);
                    acc[ai][bj][m][0] = acc[ai][bj][m][0] * r0; acc[ai][bj][m][1] = acc[ai][bj][m][1] * r1; }
    }
    __device__ __forceinline__ void operator()(const f32x4 (&acc)[2][2][4][2], const Unit& u, int wr, int wc, int fr, int fq) const {
        const int row0 = u.pm * BM + wr * 64 + fr, col0 = u.pn * BM + wc * 32 + 8 * fq, lane = fr + 16 * fq;
        const bf16_t* gb = GL + (size_t)(MT / 256) * 8 * 32768;
#pragma unroll
        for (int ai = 0; ai < 2; ++ai)
#pragma unroll
            for (int m = 0; m < 4; ++m) { const size_t row = (size_t)(row0 + ai * HALF + m * 16);
#pragma unroll
                for (int bj = 0; bj < 2; ++bj) { const int col = col0 + bj * HALF;
                    f32x4 g0, g1; unpack8(__builtin_nontemporal_load((const u32x4*)(gb + (size_t)(u.pm * 8 + 2 * u.pn + bj) * 32768 + (size_t)((((wr * 4 + wc) * 2 + ai) * 4 + m) * 512 + lane * 8))), g0, g1);
                    *(u32x4*)(MG + row * DM + col) = pack8(g0 * acc[ai][bj][m][0], g1 * acc[ai][bj][m][1]); } }
    }
};
struct EpiLnOut {
    static constexpr bool PERM = true, MID = false, AFTER = true;
    const float* X; float* O; const float* lg; const float* lb; float* stats; unsigned* cnt; int row_base, panel_base;
    __device__ __forceinline__ void operator()(const f32x4 (&)[2][2][4][2], const Unit&, int, int, int, int) const {}
    __device__ __forceinline__ void after(f32x4 (&acc)[2][2][4][2], const Unit& u, int wr, int wc, int fr, int fq, LAS unsigned char* lds) const {
        const int tid = opaque_tid();
        asm volatile("" : "+v"(fr), "+v"(fq));
        const int row0 = row_base + u.pm * BM + wr * 64 + fr, col0 = u.pn * BM + wc * 32 + 8 * fq;
        LAS float* red = (LAS float*)lds;
        LAS float* mr = red + 2048;
#pragma unroll
        for (int ai = 0; ai < 2; ++ai)
#pragma unroll
            for (int m = 0; m < 4; ++m) { float s = 0.f, q = 0.f;
#pragma unroll
                for (int bj = 0; bj < 2; ++bj) { const float* xp = X + (size_t)(row0 + ai * HALF + m * 16) * DM + col0 + bj * HALF;
                    const f32x4 x0 = __builtin_nontemporal_load((const f32x4*)xp), x1 = __builtin_nontemporal_load((const f32x4*)(xp + 4));
                    f32x4 v0 = x0 * DN_ALPHA + acc[ai][bj][m][0], v1 = x1 * DN_ALPHA + acc[ai][bj][m][1];
                    acc[ai][bj][m][0] = v0; acc[ai][bj][m][1] = v1;
                    s += ((v0[0] + v0[1]) + (v0[2] + v0[3])) + ((v1[0] + v1[1]) + (v1[2] + v1[3]));
                    q += ((v0[0] * v0[0] + v0[1] * v0[1]) + (v0[2] * v0[2] + v0[3] * v0[3])) + ((v1[0] * v1[0] + v1[1] * v1[1]) + (v1[2] * v1[2] + v1[3] * v1[3])); }
                s += __shfl_xor(s, 16); s += __shfl_xor(s, 32); q += __shfl_xor(q, 16); q += __shfl_xor(q, 32);
                if (fq == 0) { const int r = ai * HALF + wr * 64 + m * 16 + fr; red[(wc * 256 + r) * 2] = s; red[(wc * 256 + r) * 2 + 1] = q; } }
        __syncthreads();
        { const int r = tid >> 1, w = tid & 1;
          const float v = (red[(0 * 256 + r) * 2 + w] + red[(1 * 256 + r) * 2 + w]) + (red[(2 * 256 + r) * 2 + w] + red[(3 * 256 + r) * 2 + w]);
          float old = __hip_atomic_fetch_add(stats + (size_t)(row_base + u.pm * BM + r) * 2 + w, v, __ATOMIC_RELAXED, __HIP_MEMORY_SCOPE_AGENT);
          asm volatile("s_waitcnt vmcnt(0)" : "+v"(old) :: "memory"); }
        __syncthreads();
        if (tid == 0) {
            unsigned* c = cnt + (size_t)(panel_base + u.pm) * 64;
            (void)__hip_atomic_fetch_add(c, 1u, __ATOMIC_RELAXED, __HIP_MEMORY_SCOPE_AGENT);
            unsigned spins = 0;
            while (__hip_atomic_load(c, __ATOMIC_RELAXED, __HIP_MEMORY_SCOPE_AGENT) < 4u) { __builtin_amdgcn_s_sleep(1); if (++spins > (1u << 22)) break; }
        }
        __syncthreads();
        if (tid < 256) {
            const float a = __hip_atomic_load(stats + (size_t)(row_base + u.pm * BM + tid) * 2, __ATOMIC_RELAXED, __HIP_MEMORY_SCOPE_AGENT);
            const float q = __hip_atomic_load(stats + (size_t)(row_base + u.pm * BM + tid) * 2 + 1, __ATOMIC_RELAXED, __HIP_MEMORY_SCOPE_AGENT);
            const float mean = a * (1.f / DM), var = fmaxf(q * (1.f / DM) - mean * mean, 0.f);
            mr[tid * 2] = mean; mr[tid * 2 + 1] = 1.f / sqrtf(var + LN_EPS);
        }
        __syncthreads();
#pragma unroll
        for (int bj = 0; bj < 2; ++bj) { const int col = col0 + bj * HALF;
            const f32x4 g0 = *(const f32x4*)(lg + col), g1 = *(const f32x4*)(lg + col + 4), b0 = *(const f32x4*)(lb + col), b1 = *(const f32x4*)(lb + col + 4);
#pragma unroll
            for (int ai = 0; ai < 2; ++ai)
#pragma unroll
                for (int m = 0; m < 4; ++m) { const int r = ai * HALF + wr * 64 + m * 16 + fr; const float mean = mr[r * 2], rstd = mr[r * 2 + 1];
                    float* op = O + (size_t)(row0 + ai * HALF + m * 16) * DM + col;
                    *(f32x4*)op = (acc[ai][bj][m][0] - mean) * rstd * g0 + b0; *(f32x4*)(op + 4) = (acc[ai][bj][m][1] - mean) * rstd * g1 + b1; } }
        __syncthreads();
    }
};

struct P1Unit { int pm, pn, seg; };
struct P1Order {
    int G, c, rep;
    __device__ __forceinline__ bool next(int i, P1Unit& u) const {
        long L = (long)i * G + c; if (L >= 4096L * rep) return false;
        L %= 4096;
        int seg, base, nM, nN;
        if (L < 2304) { seg = 0; base = 0; nM = 128; nN = 18; } else if (L < 2816) { seg = 1; base = 2304; nM = 128; nN = 4; } else if (L < 3328) { seg = 2; base = 2816; nM = 128; nN = 4; }
        else { seg = 3 + (int)((L - 3328) >> 8); base = 3328 + 256 * (seg - 3); nM = 2; nN = 128; }
        const int nwg = nM * nN; int wgid = (int)L - base;
        { const int q = nwg / NXCD, rr = nwg % NXCD, xcd = wgid % NXCD, off = wgid / NXCD; wgid = (xcd < rr ? xcd * (q + 1) : rr * (q + 1) + (xcd - rr) * q) + off; }
        const int nig = WGM * nN, gid = wgid / nig, fm = gid * WGM, gsz = (nM - fm) < WGM ? (nM - fm) : WGM;
        u.pm = fm + ((wgid % nig) % gsz); u.pn = (wgid % nig) / gsz; u.seg = seg; return true;
    }
    static __device__ __forceinline__ int dil(int gi) { return gi == 0 ? 1 : gi == 1 ? 4 : 16; }
    static __device__ __forceinline__ size_t tok0(int t, int r) { const int b = t >> 4, q = t & 15, pos0 = q * 256, NS = SEQ / r, ph = pos0 / NS, n0 = pos0 % NS; return (size_t)(b * SEQ + n0 * r + ph); }
    static __device__ __forceinline__ int rsA(const P1Unit& u) { return u.seg == 1 ? 4 : u.seg == 2 ? 16 : 1; }
    static __device__ __forceinline__ int rsB(const P1Unit& u) { return u.seg == 4 ? 4 : u.seg == 5 ? 16 : 1; }
    static __device__ __forceinline__ int hmB(const P1Unit& u) { return (u.seg == 0 && u.pn >= 10) ? 8 : rsB(u); }
    static __device__ __forceinline__ const char* a_ptr(const P1Unit& u, const bf16_t* XB, const bf16_t* WIN) {
        if (u.seg == 0) return (const char*)XB + (size_t)u.pm * 256 * DM * 2;
        if (u.seg <= 2) return (const char*)XB + tok0(u.pm, dil(u.seg)) * DM * 2;
        return (const char*)WIN + (size_t)(2 * QKVW + (u.seg - 3) * 512 + u.pm * 256) * DM * 2;
    }
    static __device__ __forceinline__ const char* b_ptr(const P1Unit& u, const bf16_t* XB, const bf16_t* WIN) {
        if (u.seg == 0) { const int wrow = u.pn < 2 ? 256 * u.pn : u.pn < 4 ? QKVW + 256 * (u.pn - 2) : u.pn < 10 ? 3 * QKVW + 256 * (u.pn - 4) : 3 * QKVW + 1536 + 128 * (u.pn - 10);
            return (const char*)WIN + (size_t)wrow * DM * 2; }
        if (u.seg <= 2) { const int wrow = u.pn < 2 ? u.seg * 512 + 256 * u.pn : QKVW + u.seg * 512 + 256 * (u.pn - 2); return (const char*)WIN + (size_t)wrow * DM * 2; }
        return (const char*)XB + tok0(u.pn, dil(u.seg - 3)) * DM * 2;
    }
};
__device__ __forceinline__ void p1_voff(int tid, int rsa, int rsb, unsigned (&va)[2], unsigned (&vb)[2]) {
#pragma unroll
    for (int i = 0; i < 2; ++i) { int R, C; stage_rc(tid * 16 + i * 8192, R, C); const int Rb = (R & ~31) + perm32(R & 31);
        va[i] = (unsigned)(R * rsa * DM + C) * 2u; vb[i] = (unsigned)(Rb * rsb * DM + C) * 2u; }
}
constexpr int P1_TAB_OFF = 131072, P1_TAB_N = 72;
__device__ __forceinline__ bool p1_get(LAS unsigned char* lds, const P1Order& S, const bf16_t* XB, const bf16_t* WIN, int i, P1Unit& u, const char*& ap, const char*& bp) {
    if (i >= P1_TAB_N) { const bool ok = S.next(i, u); if (ok) { ap = P1Order::a_ptr(u, XB, WIN); bp = P1Order::b_ptr(u, XB, WIN); } return ok; }
    const LAS unsigned* e = (const LAS unsigned*)(lds + P1_TAB_OFF) + i * 16;
    const unsigned ok = (unsigned)__builtin_amdgcn_readfirstlane((int)e[0]);
    u.pm = __builtin_amdgcn_readfirstlane((int)e[1]); u.pn = __builtin_amdgcn_readfirstlane((int)e[2]); u.seg = __builtin_amdgcn_readfirstlane((int)e[3]);
    const unsigned long long a = ((unsigned long long)(unsigned)__builtin_amdgcn_readfirstlane((int)e[5]) << 32) | (unsigned)__builtin_amdgcn_readfirstlane((int)e[4]);
    const unsigned long long b = ((unsigned long long)(unsigned)__builtin_amdgcn_readfirstlane((int)e[7]) << 32) | (unsigned)__builtin_amdgcn_readfirstlane((int)e[6]);
    ap = (const char*)a; bp = (const char*)b;
    return ok != 0u;
}
__device__ __forceinline__ void gemm_phase_p1(LAS unsigned char* lds, const bf16_t* XB, const bf16_t* WIN, unsigned char* ws, bf16_t* GL, const P1Order& S) {
    const int tid = opaque_tid(), wid = __builtin_amdgcn_readfirstlane(tid >> 6), lane = tid & 63, wr = wid >> 2, wc = wid & 3, fr = lane & 15, fq = lane >> 4;
    constexpr int K = DM, nt = K / BK;
    const size_t kstep = (size_t)(BK * 2);
    const size_t hunit = (size_t)HALF * K * 2;
    const unsigned ldsw = (unsigned)wid * 1024u;
    const int aoff = lds_byte(wr * 64 + fr, fq * 8), boff = lds_byte(wc * 32 + fr, fq * 8);
#define PG8_SA(b, h) (((b) * 2 + (h)) * HTB)
#define PG8_SB(b, h) ((4 + (b) * 2 + (h)) * HTB)
#define PG8_STAGE(bufoff, gbase, voff) do { _Pragma("unroll") for (int _i = 0; _i < 2; ++_i) \
        __builtin_amdgcn_global_load_lds((const unsigned*)((const char*)(gbase) + (voff)[_i]), (LAS unsigned*)(lds + (bufoff) + ldsw + _i * 8192), 16, 0, 0); } while (0)
#define PG8_LDA(dst, b, h) do { _Pragma("unroll") for (int m = 0; m < 4; ++m) _Pragma("unroll") for (int k = 0; k < 2; ++k) dst[m][k] = *(const LAS bf16x8*)(lds + PG8_SA(b, h) + aoff + m * 2048 + k * 1024); } while (0)
#define PG8_LDB(dst, b, h) do { _Pragma("unroll") for (int n = 0; n < 2; ++n) _Pragma("unroll") for (int k = 0; k < 2; ++k) dst[n][k] = *(const LAS bf16x8*)(lds + PG8_SB(b, h) + boff + n * 2048 + k * 1024); } while (0)
#define PG8_MMA(ai, bj, At, Bt) do { __builtin_amdgcn_s_setprio(1); _Pragma("unroll") for (int m = 0; m < 4; ++m) _Pragma("unroll") for (int n = 0; n < 2; ++n) _Pragma("unroll") for (int k = 0; k < 2; ++k) \
        acc[ai][bj][m][n] = __builtin_amdgcn_mfma_f32_16x16x32_bf16(Bt[n][k], At[m][k], acc[ai][bj][m][n], 0, 0, 0); __builtin_amdgcn_s_setprio(0); } while (0)
#define PG8_WAIT_V(n) asm volatile("s_waitcnt vmcnt(" #n ")" ::: "memory")
#define PG8_WAIT_L(n) asm volatile("s_waitcnt lgkmcnt(" #n ")" ::: "memory")
#define PG8_BAR __builtin_amdgcn_s_barrier()
#define PG8_SCHED __builtin_amdgcn_sched_barrier(0)
    {
        LAS unsigned* tab = (LAS unsigned*)(lds + P1_TAB_OFF);
        for (int i = tid; i < P1_TAB_N; i += 512) { P1Unit u; const bool ok = S.next(i, u); if (!ok) { u.pm = 0; u.pn = 0; u.seg = 0; }
            const unsigned long long a = (unsigned long long)P1Order::a_ptr(u, XB, WIN), b = (unsigned long long)P1Order::b_ptr(u, XB, WIN);
            tab[i * 16 + 0] = ok ? 1u : 0u; tab[i * 16 + 1] = (unsigned)u.pm; tab[i * 16 + 2] = (unsigned)u.pn; tab[i * 16 + 3] = (unsigned)u.seg;
            tab[i * 16 + 4] = (unsigned)a; tab[i * 16 + 5] = (unsigned)(a >> 32); tab[i * 16 + 6] = (unsigned)b; tab[i * 16 + 7] = (unsigned)(b >> 32); }
        __syncthreads();
    }
    P1Unit cur, nxt; int ui = 0;
    const char* cA; const char* cB;
    if (!p1_get(lds, S, XB, WIN, 0, cur, cA, cB)) return;
    f32x4 acc[2][2][4][2];
#pragma unroll
    for (int a = 0; a < 2; ++a)
#pragma unroll
        for (int b = 0; b < 2; ++b)
#pragma unroll
            for (int m = 0; m < 4; ++m)
#pragma unroll
                for (int n = 0; n < 2; ++n) acc[a][b][m][n] = (f32x4){0.f, 0.f, 0.f, 0.f};
    bf16x8 At[4][2], B0[2][2], B1[2][2];
    unsigned vAc[2], vBc[2], vAn[2], vBn[2];
    p1_voff(tid, P1Order::rsA(cur), P1Order::rsB(cur), vAc, vBc);
    size_t hAc = hunit * P1Order::rsA(cur), hBc = hunit * P1Order::hmB(cur);
    PG8_STAGE(PG8_SB(0, 0), cB, vBc); PG8_STAGE(PG8_SB(0, 1), cB + hBc, vBc); PG8_STAGE(PG8_SA(0, 0), cA, vAc); PG8_STAGE(PG8_SA(0, 1), cA + hAc, vAc);
    if (wr == 1) PG8_BAR;
    PG8_WAIT_V(2); PG8_BAR;
    PG8_STAGE(PG8_SB(1, 0), cB + kstep, vBc); PG8_STAGE(PG8_SA(1, 0), cA + kstep, vAc); PG8_STAGE(PG8_SB(1, 1), cB + hBc + kstep, vBc);
    PG8_WAIT_V(6); PG8_BAR;
    for (;;) {
        const char* nA = cA; const char* nB = cB;
        const bool has_next = p1_get(lds, S, XB, WIN, ui + 1, nxt, nA, nB);
        if (!has_next) { nxt = cur; nA = cA; nB = cB; }
        p1_voff(tid, P1Order::rsA(nxt), P1Order::rsB(nxt), vAn, vBn);
        const size_t hAn = hunit * P1Order::rsA(nxt), hBn = hunit * P1Order::hmB(nxt);
        for (int t = 0; t < nt; t += 2) {
            const bool last = (t == nt - 2);
            const char* a1 = cA + (size_t)(t + 1) * kstep;
            const char* a2 = last ? nA : cA + (size_t)(t + 2) * kstep; const char* b2 = last ? nB : cB + (size_t)(t + 2) * kstep;
            const char* a3 = a2 + kstep; const char* b3 = b2 + kstep;
            unsigned vA2[2], vB2[2];
            vA2[0] = last ? vAn[0] : vAc[0]; vA2[1] = last ? vAn[1] : vAc[1]; vB2[0] = last ? vBn[0] : vBc[0]; vB2[1] = last ? vBn[1] : vBc[1];
            const size_t hA2 = last ? hAn : hAc, hB2 = last ? hBn : hBc;
            PG8_LDB(B0, 0, 0); PG8_LDB(B1, 0, 1); PG8_SCHED; PG8_LDA(At, 0, 0); PG8_STAGE(PG8_SA(1, 1), a1 + hAc, vAc);
            PG8_WAIT_V(8); PG8_WAIT_L(0); PG8_BAR; PG8_MMA(0, 0, At, B0); PG8_MMA(0, 1, At, B1); PG8_BAR; PG8_SCHED;
            PG8_LDA(At, 0, 1); PG8_STAGE(PG8_SB(0, 0), b2, vB2); PG8_STAGE(PG8_SB(0, 1), b2 + hB2, vB2); PG8_STAGE(PG8_SA(0, 0), a2, vA2);
            PG8_WAIT_V(8); PG8_WAIT_L(0); PG8_BAR; PG8_MMA(1, 0, At, B0); PG8_MMA(1, 1, At, B1); PG8_BAR; PG8_SCHED;
            PG8_LDB(B0, 1, 0); PG8_LDB(B1, 1, 1); PG8_SCHED; PG8_LDA(At, 1, 0); PG8_STAGE(PG8_SA(0, 1), a2 + hA2, vA2);
            PG8_WAIT_V(8); PG8_WAIT_L(0); PG8_BAR; PG8_MMA(0, 0, At, B0); PG8_MMA(0, 1, At, B1); PG8_BAR; PG8_SCHED;
            PG8_LDA(At, 1, 1); PG8_STAGE(PG8_SB(1, 0), b3, vB2); PG8_STAGE(PG8_SB(1, 1), b3 + hB2, vB2); PG8_STAGE(PG8_SA(1, 0), a3, vA2);
            PG8_WAIT_V(8); PG8_WAIT_L(0); PG8_BAR; PG8_MMA(1, 0, At, B0); PG8_MMA(1, 1, At, B1); PG8_BAR; PG8_SCHED;
        }
        {
            const Unit uu{cur.pm, cur.pn};
            if (cur.seg == 0) { const EpiProj E{ws, GL}; E(acc, uu, wr, wc, fr, fq); }
            else if (cur.seg <= 2) { const EpiQK E{(bf16_t*)(ws + WS_Q), (bf16_t*)(ws + WS_K), cur.seg}; E(acc, uu, wr, wc, fr, fq); }
            else { const EpiVt2 E{(bf16_t*)(ws + WS_VT), cur.seg - 3}; E(acc, uu, wr, wc, fr, fq); }
        }
        if (!has_next) break;
#pragma unroll
        for (int a = 0; a < 2; ++a)
#pragma unroll
            for (int b = 0; b < 2; ++b)
#pragma unroll
                for (int m = 0; m < 4; ++m)
#pragma unroll
                    for (int n = 0; n < 2; ++n) acc[a][b][m][n] = (f32x4){0.f, 0.f, 0.f, 0.f};
        cur = nxt; cA = nA; cB = nB; ++ui;
        vAc[0] = vAn[0]; vAc[1] = vAn[1]; vBc[0] = vBn[0]; vBc[1] = vBn[1]; hAc = hAn; hBc = hBn;
    }
    PG8_WAIT_V(0);
    if (wr == 0) PG8_BAR;
    PG8_BAR;
#undef PG8_SA
#undef PG8_SB
#undef PG8_STAGE
#undef PG8_LDA
#undef PG8_LDB
#undef PG8_MMA
#undef PG8_WAIT_V
#undef PG8_WAIT_L
#undef PG8_BAR
#undef PG8_SCHED
}
}

__device__ __forceinline__ void p0_transpose_item(const float* W, int K, int N, bf16_t* WT, LAS float* scr, int item, int lane, int ldt = 0, int koff = 0) {
    if (ldt == 0) ldt = K;
    const int nblk = N / 32, kb = item / nblk, nb = item % nblk, k0 = 64 * kb, n0 = 32 * nb;
#pragma unroll 8
    for (int i = 0; i < 32; ++i) { const int kk = 2 * i + (lane >> 5); scr[kk * 33 + (lane & 31)] = W[(size_t)(k0 + kk) * N + n0 + (lane & 31)]; }
    asm volatile("s_waitcnt lgkmcnt(0)" ::: "memory");
    const int c = lane & 7;
#pragma unroll
    for (int j = 0; j < 4; ++j) { const int n = (lane >> 3) + 8 * j; const LAS float* s = scr + (8 * c) * 33 + n;
        u32x4 o; o.x = cvt_pk_bf16(s[0 * 33], s[1 * 33]); o.y = cvt_pk_bf16(s[2 * 33], s[3 * 33]); o.z = cvt_pk_bf16(s[4 * 33], s[5 * 33]); o.w = cvt_pk_bf16(s[6 * 33], s[7 * 33]);
        *(u32x4*)(WT + (size_t)(n0 + n) * ldt + koff + k0 + 8 * c) = o; }
    asm volatile("s_waitcnt lgkmcnt(0)" ::: "memory");
}

__device__ __forceinline__ void sincos_d(double th, double& s, double& c) {
    const double k = rint(th * 0.63661977236758134308);
    const double r = fma(-k, 6.123233995736766e-17, fma(-k, 1.5707963267948966, th));
    const double r2 = r * r;
    double sp = 1.0 / 6227020800.0;
    sp = fma(sp, r2, -1.0 / 39916800.0); sp = fma(sp, r2, 1.0 / 362880.0); sp = fma(sp, r2, -1.0 / 5040.0); sp = fma(sp, r2, 1.0 / 120.0); sp = fma(sp, r2, -1.0 / 6.0); sp = fma(sp, r2, 1.0);
    const double sn = sp * r;
    double cp = -1.0 / 87178291200.0;
    cp = fma(cp, r2, 1.0 / 479001600.0); cp = fma(cp, r2, -1.0 / 3628800.0); cp = fma(cp, r2, 1.0 / 40320.0); cp = fma(cp, r2, -1.0 / 720.0); cp = fma(cp, r2, 1.0 / 24.0); cp = fma(cp, r2, -0.5); cp = fma(cp, r2, 1.0);
    const int q = ((int)k) & 3;
    s = (q == 0) ? sn : (q == 1) ? cp : (q == 2) ? -sn : -cp;
    c = (q == 0) ? cp : (q == 1) ? -sn : (q == 2) ? -cp : sn;
}
__device__ __forceinline__ double exp_small_d(double z) {
    const double y = z * (1.0 / 64.0);
    double p = 1.0 / 40320.0; p = fma(p, y, 1.0 / 5040.0); p = fma(p, y, 1.0 / 720.0); p = fma(p, y, 1.0 / 120.0); p = fma(p, y, 1.0 / 24.0); p = fma(p, y, 1.0 / 6.0); p = fma(p, y, 0.5); p = fma(p, y, 1.0); p = fma(p, y, 1.0);
#pragma unroll
    for (int i = 0; i < 6; ++i) p = p * p;
    return p;
}

struct Params { const float* in[17]; float* out; unsigned char* ws; };

constexpr int CH = 256;

__device__ __forceinline__ void phase0(const Params& p, LAS unsigned char* lds, int G) {
    const int tid = opaque_tid(), lane = tid & 63, wave = tid >> 6;
    const int gw = blockIdx.x * 8 + wave, NGW = G * 8;
    unsigned char* ws = p.ws;
    {
        const float* x = p.in[0]; bf16_t* xb = (bf16_t*)(ws + WS_XB);
        const size_t n8 = (size_t)MT * DM / 8, stride = (size_t)G * 512;
        for (size_t i = (size_t)blockIdx.x * 512 + tid; i < n8; i += stride) {
            const f32x4 a = __builtin_nontemporal_load((const f32x4*)(x + i * 8)), b = __builtin_nontemporal_load((const f32x4*)(x + i * 8 + 4));
            *(u32x4*)(xb + i * 8) = pg8::pack8(a, b);
        }
    }
    {
        LAS float* scr = (LAS float*)(lds + wave * 16384);
        constexpr int I_IN = (DM / 64) * (DIN / 32), I_GLU = (SW / 64) * (SW / 32), I_AU = (AW / 64) * (DM / 32), I_SU = (SW / 64) * (DM / 32), I_O = (DM / 64) * (DM / 32);
        constexpr int NIT = I_IN + I_GLU + I_AU + I_SU + I_O;
        for (int it = gw; it < NIT; it += NGW) {
            int r = it;
            if (r < I_IN) { p0_transpose_item(p.in[1], DM, DIN, (bf16_t*)(ws + WS_WIN), scr, r, lane); continue; } r -= I_IN;
            if (r < I_GLU) { p0_transpose_item(p.in[10], SW, SW, (bf16_t*)(ws + WS_WGLU), scr, r, lane); continue; } r -= I_GLU;
            if (r < I_AU) { p0_transpose_item(p.in[12], AW, DM, (bf16_t*)(ws + WS_WUP), scr, r, lane, 2 * AW, 0); continue; } r -= I_AU;
            if (r < I_SU) { p0_transpose_item(p.in[13], SW, DM, (bf16_t*)(ws + WS_WUP), scr, r, lane, 2 * AW, AW); continue; } r -= I_SU;
            p0_transpose_item(p.in[14], DM, DM, (bf16_t*)(ws + WS_WO), scr, r, lane);
        }
    }
    {
        const int gt = blockIdx.x * 512 + tid;
        if (gt < SG * SP) {
            const int g = gt / SP;
            float* sp = (float*)(ws + WS_SSMP);
            const double lr = (double)p.in[2][gt], li = (double)p.in[3][gt];
            const double dt = exp_small_d((double)p.in[4][g]);
            const double mag = exp_small_d(lr * dt);
            double sn, cs; sincos_d(li * dt, sn, cs);
            const double abr = mag * cs, abi = mag * sn;
            const double nr = abr - 1.0, ni = abi, den = lr * lr + li * li;
            const double cr = (nr * lr + ni * li) / den, ci = (ni * lr - nr * li) / den;
            sp[SPF_A + gt * 2] = (float)abr; sp[SPF_A + gt * 2 + 1] = (float)abi;
            const double magc = exp_small_d(lr * dt * CH); double snc, csc; sincos_d(li * dt * CH, snc, csc);
            sp[SPF_ACH + gt * 2] = (float)(magc * csc); sp[SPF_ACH + gt * 2 + 1] = (float)(magc * snc);
            const float* br = p.in[5] + (size_t)gt * SC; const float* bi = p.in[6] + (size_t)gt * SC;
            for (int c = 0; c < SC; ++c) {
                const double b_r = br[c], b_i = bi[c];
                sp[SPF_BBR + gt * SC + c] = (float)(cr * b_r - ci * b_i);
                sp[SPF_BBI + gt * SC + c] = (float)(cr * b_i + ci * b_r);
            }
        }
    }
}

struct AttnStep { int b, h, T0, g, lr, ph, jq, n0; };
__device__ __forceinline__ AttnStep attn_decode(int s, int vcu, int G, int wave) {
    AttnStep a; const int it = s / 6, rem = s - it * 6, item = vcu + it * G;
    a.b = item >> 6; a.h = (item >> 3) & 7; a.T0 = (item & 7) * 512; a.g = rem >> 1; a.lr = 2 * a.g;
    const int qi = wave * 2 + (rem & 1);
    a.ph = qi >> (4 - a.lr); a.jq = qi & ((16 >> a.lr) - 1); a.n0 = (a.T0 >> a.lr) + 32 * a.jq;
    return a;
}
__device__ __forceinline__ void attn_load_qk(const AttnStep& a, const bf16_t* Q, const bf16_t* Kb, int lane, bf16x8 (&qf)[4], bf16x8 (&kf)[5][4]) {
    int lq = lane; asm volatile("" : "+v"(lq));
    const int n = lq & 31, hh = lq >> 5;
    const int kperm = (n & 19) | ((n & 4) << 1) | ((n & 8) >> 1);
    const int p0 = a.ph * (SEQ >> a.lr);
    const bf16_t* qp = Q + pg8::qk_addr(a.b, a.g, a.h, hh, p0 + a.n0) + (size_t)n * 8;
#pragma unroll
    for (int kk = 0; kk < 4; ++kk) qf[kk] = __builtin_nontemporal_load((const bf16x8*)(qp + (size_t)kk * 2 * 32 * 8));
#pragma unroll
    for (int j = 0; j < 5; ++j) {
        const int nk0 = a.n0 - 128 + 32 * j, nkc = nk0 < 0 ? 0 : nk0;
        const bf16_t* kp = Kb + pg8::qk_addr(a.b, a.g, a.h, hh, p0 + nkc) + (size_t)kperm * 8;
#pragma unroll
        for (int kk = 0; kk < 4; ++kk) kf[j][kk] = *(const bf16x8*)(kp + (size_t)kk * 2 * 32 * 8);
    }
}
__device__ __forceinline__ void lds_wait_ge(volatile LAS unsigned* c, unsigned target) {
    unsigned spins = 0;
    while (*c < target) { __builtin_amdgcn_s_sleep(1); if (++spins > (1u << 24)) break; }
    asm volatile("" ::: "memory");
}
__device__ __forceinline__ void lds_arrive(LAS unsigned* c, int lane) {
    asm volatile("s_waitcnt lgkmcnt(0)" ::: "memory");
    if (lane == 0) (void)__hip_atomic_fetch_add(c, 1u, __ATOMIC_RELAXED, __HIP_MEMORY_SCOPE_WORKGROUP);
}
__device__ __forceinline__ void attn_phase(const Params& p, LAS unsigned char* lds, int G) {
    const int tid = opaque_tid(), lane = tid & 63, wave = __builtin_amdgcn_readfirstlane(tid >> 6);
    unsigned char* ws = p.ws;
    const bf16_t* Q = (const bf16_t*)(ws + WS_Q); const bf16_t* Kb = (const bf16_t*)(ws + WS_K); const bf16_t* Vt = (const bf16_t*)(ws + WS_VT);
    const bf16_t* ZA = (const bf16_t*)(ws + WS_ZA); bf16_t* AT = (bf16_t*)(ws + WS_AT2);
    LAS float* Obuf = (LAS float*)lds; LAS float* mbuf = (LAS float*)(lds + 131072); LAS float* lbuf = mbuf + 512;
    const float LOG2E = 1.4426950408889634f, NINF = -__builtin_inff();
    const float c1 = 0.125f * LOG2E;
    const int vcu = (G % 8 == 0) ? (int)(blockIdx.x & 7) * (G >> 3) + (int)(blockIdx.x >> 3) : (int)blockIdx.x;
    const int nitems = (512 - vcu + G - 1) / G, nsteps = nitems * 6;
    if (nsteps <= 0) return;
    LAS unsigned* cntR = (LAS unsigned*)(lds + LDS_BYTES - 64);
    LAS unsigned* cntF = cntR + 1;
    if (tid == 0) { cntR[0] = 0u; cntF[0] = 0u; }
    __syncthreads();
    bf16x8 qf[4], kf[5][4];
    { const AttnStep a0 = attn_decode(0, vcu, G, wave); attn_load_qk(a0, Q, Kb, lane, qf, kf); }
#pragma unroll 1
    for (int s = 0; s < nsteps; ++s) {
        const AttnStep a = attn_decode(s, vcu, G, wave);
        const int b = a.b, h = a.h, T0 = a.T0, g = a.g, lr = a.lr, r = 1 << lr, NS = SEQ >> lr, ph = a.ph, jq = a.jq, n0 = a.n0;
        int lq = lane; asm volatile("" : "+v"(lq));
        const int n = lq & 31, hh = lq >> 5;
        const int th0 = n - 8 * hh;
        const float c2 = exp2f(-(float)(h + 1)) * LOG2E * (float)r;
        const float sbase = -c2 * (float)(128 + th0);
        f32x16 S[5];
#pragma unroll
        for (int j = 0; j < 5; ++j)
#pragma unroll
            for (int i = 0; i < 16; ++i) S[j][i] = 0.f;
#pragma unroll
        for (int kk = 0; kk < 4; ++kk)
#pragma unroll
            for (int j = 0; j < 5; ++j) S[j] = MFMA32(kf[j][kk], qf[kk], S[j]);
        __builtin_amdgcn_sched_barrier(0);
        const bf16_t* vp = Vt + ((((size_t)(g * 8 + h) * 8 + b) * (SEQ / 8) + ((ph * NS) >> 3) + hh) * 64 + n) * 8;
        bf16x8 vf[5][2][2];
#pragma unroll
        for (int j = 0; j < 3; ++j) {
            const int nk0 = n0 - 128 + 32 * j, nkc = nk0 < 0 ? 0 : nk0;
#pragma unroll
            for (int m = 0; m < 2; ++m) { vf[j][m][0] = *(const bf16x8*)(vp + (size_t)((nkc >> 3) + 2 * m) * 512); vf[j][m][1] = *(const bf16x8*)(vp + (size_t)((nkc >> 3) + 2 * m) * 512 + 256); }
        }
        __builtin_amdgcn_sched_barrier(0);
        float mx = NINF;
#pragma unroll
        for (int j = 0; j < 5; ++j) {
            const float sbj = (n0 - 128 + 32 * j) >= 0 ? sbase : NINF;
#pragma unroll
            for (int i = 0; i < 16; ++i) {
                const int ce = 16 * (i >> 3) + (i & 7);
                float sc = fmaf(S[j][i], c1, fmaf(c2, (float)(32 * j + ce), sbj));
                if (j == 0) sc = (ce >= th0) ? sc : NINF;
                if (j == 4) sc = (ce <= th0) ? sc : NINF;
                S[j][i] = sc; mx = fmaxf(mx, sc);
            }
        }
        mx = fmaxf(mx, __shfl_xor(mx, 32));
        float ls = 0.f; bf16x8 pf[5][2];
#pragma unroll
        for (int j = 0; j < 5; ++j)
#pragma unroll
            for (int m = 0; m < 2; ++m) { u32x4 w;
#pragma unroll
                for (int q4 = 0; q4 < 4; ++q4) { const float p0 = __builtin_amdgcn_exp2f(S[j][8 * m + 2 * q4] - mx), p1 = __builtin_amdgcn_exp2f(S[j][8 * m + 2 * q4 + 1] - mx);
                    ls += p0 + p1; w[q4] = cvt_pk_bf16(p0, p1); }
                pf[j][m] = __builtin_bit_cast(bf16x8, w); }
        ls += __shfl_xor(ls, 32);
        __builtin_amdgcn_sched_barrier(0);
#pragma unroll
        for (int j = 3; j < 5; ++j) {
            const int nk0 = n0 - 128 + 32 * j, nkc = nk0 < 0 ? 0 : nk0;
#pragma unroll
            for (int m = 0; m < 2; ++m) { vf[j][m][0] = *(const bf16x8*)(vp + (size_t)((nkc >> 3) + 2 * m) * 512); vf[j][m][1] = *(const bf16x8*)(vp + (size_t)((nkc >> 3) + 2 * m) * 512 + 256); }
        }
        __builtin_amdgcn_sched_barrier(0);
        f32x16 O0, O1;
#pragma unroll
        for (int i = 0; i < 16; ++i) { O0[i] = 0.f; O1[i] = 0.f; }
#pragma unroll
        for (int j = 0; j < 5; ++j)
#pragma unroll
            for (int m = 0; m < 2; ++m) { O0 = MFMA32(vf[j][m][0], pf[j][m], O0); O1 = MFMA32(vf[j][m][1], pf[j][m], O1); }
        __builtin_amdgcn_sched_barrier(0);
        { const AttnStep an = attn_decode(s + 1 < nsteps ? s + 1 : s, vcu, G, wave); attn_load_qk(an, Q, Kb, lane, qf, kf); }
        __builtin_amdgcn_sched_barrier(0);
        const int itn = s / 6;
        if (g == 0) lds_wait_ge((volatile LAS unsigned*)cntF, 8u * (unsigned)itn); else lds_wait_ge((volatile LAS unsigned*)cntR, 8u * (unsigned)(6 * itn + 2 * g));
        const int row = (32 * jq + n) * r + ph;
        const int gsw = (row ^ (row >> 4)) & 15;
        float mo = NINF, lo_ = 0.f;
        if (g > 0) { mo = mbuf[row]; lo_ = lbuf[row]; }
        const float mn = fmaxf(mo, mx); const float al = __builtin_amdgcn_exp2f(mo - mn), be = __builtin_amdgcn_exp2f(mx - mn);
#pragma unroll
        for (int dt = 0; dt < 2; ++dt)
#pragma unroll
            for (int j4 = 0; j4 < 4; ++j4) {
                const int chunk = 8 * dt + 2 * j4 + hh;
                LAS f32x4* ptr = (LAS f32x4*)(Obuf + row * 64 + ((chunk ^ gsw) * 4));
                f32x4 o;
                if (dt == 0) o = (f32x4){O0[4 * j4], O0[4 * j4 + 1], O0[4 * j4 + 2], O0[4 * j4 + 3]}; else o = (f32x4){O1[4 * j4], O1[4 * j4 + 1], O1[4 * j4 + 2], O1[4 * j4 + 3]};
                o = o * be;
                if (g > 0) o += *ptr * al;
                *ptr = o;
            }
        if (hh == 0) { mbuf[row] = mn; lbuf[row] = lo_ * al + ls * be; }
        const int rem = s % 6;
        lds_arrive(cntR, lane);
        if (rem == 5) {
            lds_wait_ge((volatile LAS unsigned*)cntR, 48u * (unsigned)(itn + 1));
            u32x4 zz[8];
#pragma unroll
            for (int it = 0; it < 8; ++it) { const int idx = it * 512 + tid, row2 = idx >> 3, dc = idx & 7; zz[it] = __builtin_nontemporal_load((const u32x4*)(ZA + (size_t)(((b * 16 + ((T0 + row2) >> 8)) * 2 + (h >> 2))) * 65536
                    + pg8::tp_off((row2 >> 6) & 1, (h & 1) * 2 + (dc >> 2), (row2 >> 7) & 1, (row2 >> 4) & 3, (h >> 1) & 1, (row2 & 15) + 16 * (dc & 3)))); }
#pragma unroll
            for (int it = 0; it < 8; ++it) {
                const int idx = it * 512 + tid, row2 = idx >> 3, dc = idx & 7, gs2 = (row2 ^ (row2 >> 4)) & 15;
                const f32x4 a0 = *(const LAS f32x4*)(Obuf + row2 * 64 + (((2 * dc) ^ gs2) * 4)), a1 = *(const LAS f32x4*)(Obuf + row2 * 64 + (((2 * dc + 1) ^ gs2) * 4));
                const float inv = 1.f / lbuf[row2];
                f32x4 z0, z1; pg8::unpack8(zz[it], z0, z1);
                f32x4 o0, o1;
#pragma unroll
                for (int j = 0; j < 4; ++j) { o0[j] = a0[j] * inv * z0[j]; o1[j] = a1[j] * inv * z1[j]; }
                *(u32x4*)(AT + ((size_t)b * SEQ + T0 + row2) * (2 * AW) + h * 64 + 8 * dc) = pg8::pack8(o0, o1);
            }
            lds_arrive(cntF, lane);
        }
    }
    __syncthreads();
}

constexpr int XS_PITCH = 272, XS_WAVE = 32 * XS_PITCH;
#define MFMA16(a, b, c) __builtin_amdgcn_mfma_f32_16x16x32_bf16((a), (b), (c), 0, 0, 0)
__device__ __forceinline__ bf16x8 pack_bf8(f32x4 a, f32x4 b) { return __builtin_bit_cast(bf16x8, pg8::pack8(a, b)); }
template <int PASS>
__device__ __forceinline__ void ssm_pass(const Params& p, LAS unsigned char* lds, int G) {
    const int tid = opaque_tid(), lane = tid & 63, wave = __builtin_amdgcn_readfirstlane(tid >> 6);
    const int n = lane & 31, hh = lane >> 5;
    unsigned char* ws = p.ws;
    const float* sp = (const float*)(ws + WS_SSMP);
    const bf16_t* US = (const bf16_t*)(ws + WS_US); bf16_t* YG = (bf16_t*)(ws + WS_YG);
    float* CHS = (float*)(ws + WS_CHST);
    LAS unsigned char* xs = lds + wave * XS_WAVE;
    const int seqA = (n >> 2) & 1, qA = 4 * (n >> 3) + (n & 3);
    unsigned* ssmc = (unsigned*)(ws + WS_SSMC);
    if (PASS == 2) {
        unsigned spins = 0;
        while (__builtin_amdgcn_readfirstlane(__hip_atomic_load(ssmc, __ATOMIC_RELAXED, __HIP_MEMORY_SCOPE_AGENT)) < (unsigned)(SG * 4 * (SEQ / CH))) { __builtin_amdgcn_s_sleep(2); if (++spins > (1u << 22)) break; }
    }
    unsigned njobs = 0;
    for (int job = blockIdx.x * 8 + wave; job < SG * 4 * (SEQ / CH); job += G * 8) {
        const int g = job & 31, pair = (job >> 5) & 3, chunk = job >> 7;
        ++njobs;
        if (PASS == 1 && chunk == SEQ / CH - 1) continue;
        bf16x8 bre[2], bim[2]; float ar[2], ai[2], xr[2], xi[2];
#pragma unroll
        for (int pt = 0; pt < 2; ++pt) {
            const int gp = g * SP + 32 * pt + n;
            const float* br = sp + SPF_BBR + (size_t)gp * SC + 8 * hh; const float* bi = sp + SPF_BBI + (size_t)gp * SC + 8 * hh;
            bre[pt] = pack_bf8(*(const f32x4*)br, *(const f32x4*)(br + 4)); bim[pt] = pack_bf8(*(const f32x4*)bi, *(const f32x4*)(bi + 4));
            ar[pt] = sp[SPF_A + gp * 2]; ai[pt] = sp[SPF_A + gp * 2 + 1];
            xr[pt] = 0.f; xi[pt] = 0.f;
        }
        const int bme = pair + 4 * hh;
        if (PASS == 2) {
#pragma unroll
            for (int pt = 0; pt < 2; ++pt) {
                const int gp = g * SP + 32 * pt + n;
                const float cr = sp[SPF_ACH + gp * 2], ci = sp[SPF_ACH + gp * 2 + 1];
                const float* e = CHS + ((size_t)((bme * SG + g) * (SEQ / CH)) * SP + 32 * pt + n) * 2;
                float sr = 0.f, si = 0.f;
                for (int i = 0; i < chunk; ++i) { const f32x2 ev = __builtin_bit_cast(f32x2, __hip_atomic_load((const unsigned long long*)(e + (size_t)i * SP * 2), __ATOMIC_RELAXED, __HIP_MEMORY_SCOPE_AGENT)); const float nr = cr * sr - ci * si + ev.x, ni = cr * si + ci * sr + ev.y; sr = nr; si = ni; }
                xr[pt] = sr; xi[pt] = si;
            }
        }
        bf16x8 cm[4]; f32x4 dsk;
        if (PASS == 2) {
            const int c = lane & 15, pq = 4 * (lane >> 4);
#pragma unroll
            for (int kk = 0; kk < 4; ++kk) {
                const f32x4 cr = *(const f32x4*)(p.in[7] + (size_t)(g * SC + c) * SP + pq + 16 * kk), ci = *(const f32x4*)(p.in[8] + (size_t)(g * SC + c) * SP + pq + 16 * kk);
                cm[kk] = pack_bf8((f32x4){cr.x, -ci.x, cr.y, -ci.y}, (f32x4){cr.z, -ci.z, cr.w, -ci.w});
            }
            dsk = *(const f32x4*)(p.in[9] + g * SC + 4 * (lane >> 4));
        }
        const bf16_t* up = US + (size_t)((((pair + 4 * seqA) * 16 + chunk) * 2 + (g >> 4))) * 65536 + pg8::tp_off(0, (g >> 1) & 3, 0, 0, (g >> 3) & 1, qA + 16 * ((g & 1) * 2 + hh));
#define US_STEP(st_) ((size_t)((((st_) >> 3) & 1) * 4096 + (((st_) >> 2) & 1) * 32768 + ((st_) & 3) * 1024))
        bf16x8 ufn = *(const bf16x8*)up;
#pragma unroll 1
        for (int st = 0; st < CH / 16; ++st) {
            const bf16x8 uf = ufn;
            ufn = *(const bf16x8*)(up + US_STEP(st + 1 < CH / 16 ? st + 1 : st));
            u32x2 uu[2];
            if (PASS == 2) {
#pragma unroll
                for (int sq = 0; sq < 2; ++sq) uu[sq] = *(const u32x2*)(US + (size_t)((((pair + 4 * sq) * 16 + chunk) * 2 + (g >> 4))) * 65536
                    + pg8::tp_off(0, (g >> 1) & 3, 0, 0, (g >> 3) & 1, (lane & 15) + 16 * ((g & 1) * 2 + (lane >> 5))) + US_STEP(st) + ((lane >> 4) & 1) * 4);
            }
#pragma unroll
            for (int pt = 0; pt < 2; ++pt) {
                f32x16 z;
#pragma unroll
                for (int i = 0; i < 16; ++i) z[i] = 0.f;
                const f32x16 accR = MFMA32(uf, bre[pt], z), accI = MFMA32(uf, bim[pt], z);
#pragma unroll
                for (int i = 0; i < 16; ++i) {
                    const float nr = fmaf(ar[pt], xr[pt], fmaf(-ai[pt], xi[pt], accR[i])), ni = fmaf(ar[pt], xi[pt], fmaf(ai[pt], xr[pt], accI[i]));
                    xr[pt] = nr; xi[pt] = ni;
                    if (PASS == 2) *(LAS unsigned*)(xs + (hh * 16 + i) * XS_PITCH + (32 * pt + n) * 4) = cvt_pk_bf16(nr, ni);
                }
            }
            if (PASS == 2) {
#pragma unroll
                for (int sq = 0; sq < 2; ++sq) {
                    f32x4 y = (f32x4){0.f, 0.f, 0.f, 0.f};
#pragma unroll
                    for (int kk = 0; kk < 4; ++kk) {
                        const bf16x8 xb = *(const LAS bf16x8*)(xs + (sq * 16 + (lane & 15)) * XS_PITCH + (8 * (lane >> 4) + 32 * kk) * 2);
                        y = MFMA16(cm[kk], xb, y);
                    }
                    const size_t off = ((size_t)(pair + 4 * sq) * SEQ + chunk * CH + st * 16 + (lane & 15)) * SW + g * SC + 4 * (lane >> 4);
                    const float o0 = gelu_tanh(y[0] + dsk[0] * bf_lo(uu[sq].x)), o1 = gelu_tanh(y[1] + dsk[1] * bf_hi(uu[sq].x)), o2 = gelu_tanh(y[2] + dsk[2] * bf_lo(uu[sq].y)), o3 = gelu_tanh(y[3] + dsk[3] * bf_hi(uu[sq].y));
                    u32x2 w; w.x = cvt_pk_bf16(o0, o1); w.y = cvt_pk_bf16(o2, o3);
                    *(u32x2*)(YG + off) = w;
                }
            }
        }
        if (PASS == 1) {
#pragma unroll
            for (int pt = 0; pt < 2; ++pt) {
                float* e = CHS + ((size_t)((bme * SG + g) * (SEQ / CH) + chunk) * SP + 32 * pt + n) * 2;
                __hip_atomic_store((unsigned long long*)e, __builtin_bit_cast(unsigned long long, (f32x2){xr[pt], xi[pt]}), __ATOMIC_RELAXED, __HIP_MEMORY_SCOPE_AGENT);
            }
        }
    }
    if (PASS == 1) {
        asm volatile("s_waitcnt vmcnt(0)" ::: "memory");
        if (lane == 0 && njobs) (void)__hip_atomic_fetch_add(ssmc, njobs, __ATOMIC_RELAXED, __HIP_MEMORY_SCOPE_AGENT);
    }
}

__device__ __forceinline__ void ln_phase(const Params& p, int G) {
    const int tid = opaque_tid(), lane = tid & 63, wave = tid >> 6;
    const int gw = blockIdx.x * 8 + wave, NGW = G * 8;
    const float* lg = p.in[15]; const float* lb = p.in[16];
    f32x4 gg[4], bb[4];
#pragma unroll
    for (int j = 0; j < 4; ++j) { gg[j] = *(const f32x4*)(lg + (lane + 64 * j) * 4); bb[j] = *(const f32x4*)(lb + (lane + 64 * j) * 4); }
    for (int m = gw; m < MT; m += NGW) {
        f32x4* row = (f32x4*)(p.out + (size_t)m * DM) + lane;
        f32x4 v[4]; float s = 0.f;
#pragma unroll
        for (int j = 0; j < 4; ++j) { v[j] = row[64 * j]; s += (v[j].x + v[j].y) + (v[j].z + v[j].w); }
        const float mean = wave_sum(s) * (1.f / DM); float s2 = 0.f;
#pragma unroll
        for (int j = 0; j < 4; ++j) { v[j] = v[j] - mean; s2 += (v[j].x * v[j].x + v[j].y * v[j].y) + (v[j].z * v[j].z + v[j].w * v[j].w); }
        const float rstd = 1.f / sqrtf(wave_sum(s2) * (1.f / DM) + LN_EPS);
#pragma unroll
        for (int j = 0; j < 4; ++j) row[64 * j] = v[j] * rstd * gg[j] + bb[j];
    }
}

#define RLX_AGENT __ATOMIC_RELAXED, __HIP_MEMORY_SCOPE_AGENT
#define XB_TMO      128
#define XB_XCNT(j)  (256  + 64 * (j))
#define XB_XSUB(j)  (1280 + 64 * (j))
#define XB_XGEN(j)  (2304 + 64 * (j))
#define XB_TOP      3328
#define XB_TOPGEN   3392
#define XCD_BAR_WORDS 3456
#define XB_SPIN_CAP (1u << 18)

__device__ __forceinline__ unsigned xb_ld(unsigned* p)              { return __hip_atomic_load(p, __ATOMIC_RELAXED, __HIP_MEMORY_SCOPE_AGENT); }
__device__ __forceinline__ unsigned xb_add(unsigned* p, unsigned v) { return __hip_atomic_fetch_add(p, v, __ATOMIC_RELAXED, __HIP_MEMORY_SCOPE_AGENT); }
__device__ __forceinline__ unsigned xb_xcc_id() { return (unsigned)__builtin_amdgcn_s_getreg((3 << 11) | 20) & 0xFu; }
#define XB_SPIN(cond, bar) do { unsigned _sp = 0; while (cond) { __builtin_amdgcn_s_sleep(1); \
    if ((++_sp & 255u) == 0u) { if (xb_ld(&(bar)[XB_TMO])) break; if (_sp > XB_SPIN_CAP) { atomicAdd(&(bar)[XB_TMO], 1u); break; } } } } while (0)

struct XcdBarrier {
    unsigned* bar; unsigned x;
    volatile LAS unsigned* st;
};

__device__ __forceinline__ XcdBarrier xcd_barrier_post(unsigned* bar, volatile LAS unsigned* st) {
    XcdBarrier b; b.bar = bar; b.x = xb_xcc_id(); b.st = st;
    if (threadIdx.x == 0) (void)xb_add(&bar[XB_XCNT(b.x)], 1u);
    return b;
}
__device__ __forceinline__ void xcd_barrier_complete(unsigned* bar, unsigned x, unsigned& nloc, unsigned& nx) {
    const unsigned G = gridDim.x * gridDim.y * gridDim.z;
    unsigned sum, cnt, mine, sp = 0u;
    for (;;) {
        sum = 0u; cnt = 0u; mine = 0u;
#pragma unroll
        for (unsigned j = 0; j < 16; ++j) { const unsigned c = xb_ld(&bar[XB_XCNT(j)]); sum += c; cnt += (c > 0u) ? 1u : 0u; mine = (j == x) ? c : mine; }
        if (sum == G) break;
        __builtin_amdgcn_s_sleep(1);
        if ((++sp & 255u) == 0u) { if (xb_ld(&bar[XB_TMO])) break; if (sp > XB_SPIN_CAP) { atomicAdd(&bar[XB_TMO], 1u); break; } }
    }
    nloc = mine > 0u ? mine : 1u; nx = cnt > 0u ? cnt : 1u;
}

__device__ __forceinline__ void xcd_barrier(const XcdBarrier& b) {
    asm volatile("s_waitcnt vmcnt(0)" ::: "memory");
    __syncthreads();
    if (threadIdx.x == 0) {
        unsigned* bar = b.bar;
        __builtin_amdgcn_s_waitcnt(0);
        unsigned nloc = b.st[0], nx = b.st[1];
        if (nloc == 0u) { xcd_barrier_complete(bar, b.x, nloc, nx); b.st[0] = nloc; b.st[1] = nx; }
        const unsigned old = xb_add(&bar[XB_XSUB(b.x)], 1u);
        const unsigned gen = old / nloc;
        if (old + 1u == (gen + 1u) * nloc) {
            __builtin_amdgcn_fence(__ATOMIC_RELEASE, "agent");
            asm volatile("s_waitcnt vmcnt(0)" ::: "memory");
            const unsigned og = xb_add(&bar[XB_TOP], 1u);
            const unsigned tg = og / nx;
            if (og + 1u == (tg + 1u) * nx) xb_add(&bar[XB_TOPGEN], 1u);
            else XB_SPIN(xb_ld(&bar[XB_TOPGEN]) == tg, bar);
            __builtin_amdgcn_fence(__ATOMIC_ACQUIRE, "agent");
            xb_add(&bar[XB_XGEN(b.x)], 1u);
            asm volatile("s_waitcnt vmcnt(0)" ::: "memory");
        } else {
            XB_SPIN(xb_ld(&bar[XB_XGEN(b.x)]) == gen, bar);
            __builtin_amdgcn_fence(__ATOMIC_ACQUIRE, "agent");
            asm volatile("s_waitcnt vmcnt(0)" ::: "memory");
        }
    }
    __syncthreads();
}


#ifndef REP_P0
#define REP_P0 1
#endif
#ifndef REP_P1
#define REP_P1 1
#endif
#ifndef REP_ATT
#define REP_ATT 1
#endif
#ifndef REP_SSM
#define REP_SSM 1
#endif
#ifndef REP_P4
#define REP_P4 1
#endif
#ifndef REP_P5
#define REP_P5 1
#endif
#ifndef REP_P6
#define REP_P6 1
#endif
#ifndef REP_SYNC
#define REP_SYNC 1
#endif
__global__ void __launch_bounds__(512, 2) mega_fwd(Params p) {
    extern __shared__ __attribute__((aligned(16))) unsigned char lds_raw[];
    LAS unsigned char* lds = (LAS unsigned char*)lds_raw;
    cg::grid_group grid = cg::this_grid();
    const int G = gridDim.x;
    unsigned char* ws = p.ws;
    bf16_t* XB = (bf16_t*)(ws + WS_XB); bf16_t* WIN = (bf16_t*)(ws + WS_WIN);
    bf16_t* GL = (bf16_t*)p.out;
    volatile LAS unsigned* bst = (volatile LAS unsigned*)(lds + LDS_BYTES - 16);
    if (threadIdx.x < 4) bst[threadIdx.x] = 0u;
    __syncthreads();
    const XcdBarrier xbar = xcd_barrier_post((unsigned*)(ws + WS_BAR), bst);
#define GRID_BAR() xcd_barrier(xbar)

#pragma unroll 1
    for (int rep = 0; rep < REP_P0; ++rep) { phase0(p, lds, G); __syncthreads(); }
    if (p.ws == nullptr) grid.sync();
#pragma unroll 1
    for (int rep = 0; rep < REP_SYNC; ++rep) GRID_BAR();

    {
        pg8::P1Order S{G, (int)blockIdx.x, REP_P1};
        pg8::gemm_phase_p1(lds, XB, WIN, ws, GL, S);
    }
    GRID_BAR();

    ssm_pass<1>(p, lds, G);
    __syncthreads();
#pragma unroll 1
    for (int rep = 0; rep < REP_ATT; ++rep) attn_phase(p, lds, G);
#pragma unroll 1
    for (int rep = 0; rep < REP_SSM; ++rep) ssm_pass<2>(p, lds, G);
    GRID_BAR();

    {
        pg8::Gemm g{(const bf16_t*)(ws + WS_YG), (const bf16_t*)(ws + WS_WGLU), SW, 1, 1}; pg8::Order S; S.init(MT / 256, SW / 256, G, (int)blockIdx.x, 0, 1, REP_P4);
        pg8::EpiGlu E{(const bf16_t*)(ws + WS_YG), (const bf16_t*)(ws + WS_ZS), p.in[11], (bf16_t*)(ws + WS_AT2)};
        pg8::gemm_phase<pg8::EpiGlu>(lds, g, S, E);
    }
    GRID_BAR();

    {
        pg8::Gemm g{(const bf16_t*)(ws + WS_AT2), (const bf16_t*)(ws + WS_WUP), 2 * AW, 1, 1}; pg8::Order S; S.init(MT / 256, DM / 256, G, (int)blockIdx.x, 0, 1, REP_P5);
        pg8::EpiMerge E{GL, (bf16_t*)(ws + WS_MG)};
        pg8::gemm_phase<pg8::EpiMerge>(lds, g, S, E);
    }
    GRID_BAR();

#pragma unroll 1
    for (int hc = 0; hc < 2; ++hc) {
        pg8::Gemm g{(const bf16_t*)(ws + WS_MG) + (size_t)hc * (MT / 2) * DM, (const bf16_t*)(ws + WS_WO), DM, 1, 1}; pg8::Order S; S.init(MT / 512, DM / 256, G, (int)blockIdx.x, 0, 1, 1);
        pg8::EpiLnOut E{p.in[0], p.out, p.in[15], p.in[16], (float*)(ws + WS_STATS), (unsigned*)(ws + WS_CNT), hc * (MT / 2), hc * (MT / 512)};
        pg8::gemm_phase<pg8::EpiLnOut>(lds, g, S, E);
    }
}

extern "C" void kernel_launch(void* const* d_in, const int* in_sizes, int n_in, void* d_out, int out_size, void* d_ws, size_t ws_size, hipStream_t stream) {
    static int grid = 0;
    if (grid == 0) {
        if (n_in != 17 || out_size != MT * DM || ws_size < WS_END) { fprintf(stderr, "kernel_launch: unexpected shapes (n_in %d out %d ws %zu)\n", n_in, out_size, ws_size); grid = -1; return; }
        int dev = 0, cus = 0, per_cu = 0;
        hipGetDevice(&dev);
        hipDeviceGetAttribute(&cus, hipDeviceAttributeMultiprocessorCount, dev);
        hipFuncSetAttribute((const void*)mega_fwd, hipFuncAttributeMaxDynamicSharedMemorySize, LDS_BYTES);
        hipOccupancyMaxActiveBlocksPerMultiprocessor(&per_cu, (const void*)mega_fwd, 512, LDS_BYTES);
        if (per_cu < 1) { fprintf(stderr, "kernel_launch: occupancy query says %d blocks per CU\n", per_cu); per_cu = 1; }
        grid = cus;
        (void)hipGetLastError();
    }
    if (grid < 0) return;
    Params p{};
    for (int i = 0; i < 17; ++i) p.in[i] = (const float*)d_in[i];
    p.out = (float*)d_out; p.ws = (unsigned char*)d_ws;
    if (hipMemsetAsync((char*)d_ws + WS_BAR, 0, BAR_BYTES, stream) != hipSuccess) { fprintf(stderr, "kernel_launch: memset failed\n"); return; }
    void* args[] = {&p};
    hipError_t e = hipLaunchCooperativeKernel((const void*)mega_fwd, dim3(grid), dim3(512), args, LDS_BYTES, stream);
    if (e != hipSuccess) fprintf(stderr, "cooperative launch failed: %s (grid %d)\n", hipGetErrorString(e), grid);
}
```
